# Optimizing an MI355X kernel written in HIP

```python
import math
import jax, jax.numpy as jnp
from jax import lax
import numpy as np

D_MODEL = 1024
BATCH = 8
SEQ = 4096
DEPTH = 1

HEAD_DIM = 64
MIX_WIDTH = D_MODEL
SB_WIDTH = MIX_WIDTH // 2
SB_HEADS = SB_WIDTH // HEAD_DIM
DF_V_DIM = 2 * HEAD_DIM
DF_WIDTH = MIX_WIDTH - SB_WIDTH
DF_HEADS = DF_WIDTH // DF_V_DIM
DF_QK_WIDTH = DF_HEADS * 2 * HEAD_DIM
IN_PROJ_WIDTH = 3 * SB_WIDTH + 2 * DF_QK_WIDTH + DF_WIDTH
SCALE = HEAD_DIM ** -0.5
Q_BLOCK = 128
ALIBI_SLOPES = tuple(2.0 ** (-8.0 * (h + 1) / DF_HEADS) for h in range(DF_HEADS))
N_GROUPS = 4
EXPERTS_PER_GROUP = 4
N_EXPERTS = N_GROUPS * EXPERTS_PER_GROUP
TOP_K_IN_GROUP = 2
D_EXPERT = D_MODEL // 2
PLE_DIM = 256
NORM_EPS = 1e-6

kernel_name = 'hymba_stickbreak_diffattn_hmoe_ple'


def _rmsnorm(x, g):
    xf = x.astype(jnp.float32)
    y = xf * lax.rsqrt(jnp.mean(xf * xf, axis=-1, keepdims=True) + NORM_EPS)
    return (y * g.astype(jnp.float32)).astype(x.dtype)


def _stick_breaking_block(q_blk, k_pre, v_pre, q_start):
    n_keys = k_pre.shape[2]
    z = jnp.einsum('bhqd,bhkd->bhqk', q_blk, k_pre).astype(jnp.float32) * SCALE
    t_pos = q_start + jnp.arange(Q_BLOCK)[:, None]
    s_pos = jnp.arange(n_keys)[None, :]
    strict = s_pos < t_pos
    log_beta = jax.nn.log_sigmoid(z)
    log_keep = jnp.where(strict, jax.nn.log_sigmoid(-z), 0.0)
    log_survive = lax.cumsum(log_keep, axis=3, reverse=True) - log_keep
    weights = jnp.where(strict, jnp.exp(log_beta + log_survive), 0.0)
    return jnp.einsum('bhqk,bhkd->bhqd', weights.astype(v_pre.dtype), v_pre)


def _differential_block(q_blk, k_pre, v_pre, q_start, lam, slopes):
    n_keys = k_pre.shape[3]
    z = jnp.einsum('bhcqd,bhckd->bhcqk', q_blk, k_pre).astype(jnp.float32) * SCALE
    t_pos = q_start + jnp.arange(Q_BLOCK)[:, None]
    s_pos = jnp.arange(n_keys)[None, :]
    dist = (t_pos - s_pos).astype(jnp.float32)
    z = z - slopes[None, :, None, None, None] * dist
    z = jnp.where(s_pos <= t_pos, z, -jnp.inf)
    probs = jax.nn.softmax(z, axis=-1)
    attn = probs[:, :, 0] - lam * probs[:, :, 1]
    return jnp.einsum('bhqk,bhkd->bhqd', attn.astype(v_pre.dtype), v_pre)


def _hybrid_layer(x, p_i, layer_idx, g_mix, w_in, lambda_q1, lambda_k1, lambda_q2,
                  lambda_k2, g_sb_out, g_df_out, w_out, g_ffn, w_router_group,
                  b_router_group, w_router_expert, b_router_expert, w_expert_gate,
                  w_expert_up, w_expert_down, g_ple, w_ple_gate, w_ple_proj):
    bsz, seq, _ = x.shape
    h = _rmsnorm(x, g_mix)
    proj = h @ w_in
    q_sb, k_sb, v_sb, q_df, k_df, v_df = jnp.split(
        proj, [SB_WIDTH, 2 * SB_WIDTH, 3 * SB_WIDTH,
               3 * SB_WIDTH + DF_QK_WIDTH, 3 * SB_WIDTH + 2 * DF_QK_WIDTH], axis=-1)
    q_sb = q_sb.reshape(bsz, seq, SB_HEADS, HEAD_DIM).transpose(0, 2, 1, 3)
    k_sb = k_sb.reshape(bsz, seq, SB_HEADS, HEAD_DIM).transpose(0, 2, 1, 3)
    v_sb = v_sb.reshape(bsz, seq, SB_HEADS, HEAD_DIM).transpose(0, 2, 1, 3)
    q_df = q_df.reshape(bsz, seq, DF_HEADS, 2, HEAD_DIM).transpose(0, 2, 3, 1, 4)
    k_df = k_df.reshape(bsz, seq, DF_HEADS, 2, HEAD_DIM).transpose(0, 2, 3, 1, 4)
    v_df = v_df.reshape(bsz, seq, DF_HEADS, DF_V_DIM).transpose(0, 2, 1, 3)

    lambda_init = 0.8 - 0.6 * math.exp(-0.3 * layer_idx)
    lam = (jnp.exp(jnp.sum(lambda_q1.astype(jnp.float32) * lambda_k1.astype(jnp.float32)))
           - jnp.exp(jnp.sum(lambda_q2.astype(jnp.float32) * lambda_k2.astype(jnp.float32)))
           + lambda_init)
    slopes = jnp.asarray(ALIBI_SLOPES, dtype=jnp.float32)

    sb_blocks, df_blocks = [], []
    for blk in range(seq // Q_BLOCK):
        qs = blk * Q_BLOCK
        qe = qs + Q_BLOCK
        sb_blocks.append(_stick_breaking_block(q_sb[:, :, qs:qe], k_sb[:, :, :qe],
                                               v_sb[:, :, :qe], qs))
        df_blocks.append(_differential_block(q_df[:, :, :, qs:qe], k_df[:, :, :, :qe],
                                             v_df[:, :, :qe], qs, lam, slopes))
    o_sb = jnp.concatenate(sb_blocks, axis=2).transpose(0, 2, 1, 3).reshape(bsz, seq, SB_WIDTH)
    o_sb = _rmsnorm(o_sb, g_sb_out)
    o_df = jnp.concatenate(df_blocks, axis=2)
    o_df = _rmsnorm(o_df, g_df_out) * (1.0 - lambda_init)
    o_df = o_df.transpose(0, 2, 1, 3).reshape(bsz, seq, DF_WIDTH)
    x = x + jnp.concatenate([o_sb, o_df], axis=-1) @ w_out

    h2 = _rmsnorm(x, g_ffn).reshape(-1, D_MODEL)
    group_logits = (h2 @ w_router_group).astype(jnp.float32) + b_router_group.astype(jnp.float32)
    group_probs = jax.nn.softmax(group_logits, axis=-1)
    g_idx = jnp.argmax(group_logits, axis=-1)
    g_w = jnp.take_along_axis(group_probs, g_idx[:, None], axis=1)[:, 0]
    expert_logits = ((h2 @ w_router_expert).astype(jnp.float32)
                     + b_router_expert.astype(jnp.float32)).reshape(-1, N_GROUPS, EXPERTS_PER_GROUP)
    in_group = jnp.take_along_axis(expert_logits, g_idx[:, None, None], axis=1)[:, 0]
    top_vals, top_idx = lax.top_k(in_group, TOP_K_IN_GROUP)
    top_w = jax.nn.softmax(top_vals, axis=-1) * g_w[:, None]
    expert_ids = g_idx[:, None] * EXPERTS_PER_GROUP + top_idx
    gates = jnp.sum(jax.nn.one_hot(expert_ids, N_EXPERTS, dtype=jnp.float32)
                    * top_w[..., None], axis=1).astype(h2.dtype)
    y = jnp.zeros_like(h2)
    for e in range(N_EXPERTS):
        hid = jax.nn.silu(h2 @ w_expert_gate[e]) * (h2 @ w_expert_up[e])
        y = y + gates[:, e:e + 1] * (hid @ w_expert_down[e])
    x = x + y.reshape(bsz, seq, D_MODEL)

    gate = jax.nn.sigmoid(_rmsnorm(x, g_ple) @ w_ple_gate)
    x = x + gate * (p_i @ w_ple_proj)
    return x


def setup_inputs(seed: int = 0) -> dict:
    key = jax.random.key(seed)
    ks = jax.random.split(key, 23)
    f32 = jnp.float32

    def nrm(k, shape, scale):
        return jax.random.normal(k, shape, f32) * scale

    def gain(k, shape):
        return 1.0 + 0.02 * jax.random.normal(k, shape, f32)

    return {
        'x': nrm(ks[0], (BATCH, SEQ, D_MODEL), 1.0),
        'p': nrm(ks[1], (DEPTH, BATCH, SEQ, PLE_DIM), 1.0),
        'g_mix': gain(ks[2], (DEPTH, D_MODEL)),
        'w_in': nrm(ks[3], (DEPTH, D_MODEL, IN_PROJ_WIDTH), D_MODEL ** -0.5),
        'lambda_q1': nrm(ks[4], (DEPTH, HEAD_DIM), 0.1),
        'lambda_k1': nrm(ks[5], (DEPTH, HEAD_DIM), 0.1),
        'lambda_q2': nrm(ks[6], (DEPTH, HEAD_DIM), 0.1),
        'lambda_k2': nrm(ks[7], (DEPTH, HEAD_DIM), 0.1),
        'g_sb_out': gain(ks[8], (DEPTH, SB_WIDTH)),
        'g_df_out': gain(ks[9], (DEPTH, DF_V_DIM)),
        'w_out': nrm(ks[10], (DEPTH, MIX_WIDTH, D_MODEL), MIX_WIDTH ** -0.5),
        'g_ffn': gain(ks[11], (DEPTH, D_MODEL)),
        'w_router_group': nrm(ks[12], (DEPTH, D_MODEL, N_GROUPS), D_MODEL ** -0.5),
        'b_router_group': nrm(ks[13], (DEPTH, N_GROUPS), 0.01),
        'w_router_expert': nrm(ks[14], (DEPTH, D_MODEL, N_EXPERTS), D_MODEL ** -0.5),
        'b_router_expert': nrm(ks[15], (DEPTH, N_EXPERTS), 0.01),
        'w_expert_gate': nrm(ks[16], (DEPTH, N_EXPERTS, D_MODEL, D_EXPERT), D_MODEL ** -0.5),
        'w_expert_up': nrm(ks[17], (DEPTH, N_EXPERTS, D_MODEL, D_EXPERT), D_MODEL ** -0.5),
        'w_expert_down': nrm(ks[18], (DEPTH, N_EXPERTS, D_EXPERT, D_MODEL), D_EXPERT ** -0.5),
        'g_ple': gain(ks[19], (DEPTH, D_MODEL)),
        'w_ple_gate': nrm(ks[20], (DEPTH, D_MODEL, D_MODEL), D_MODEL ** -0.5),
        'w_ple_proj': nrm(ks[21], (DEPTH, PLE_DIM, D_MODEL), PLE_DIM ** -0.5),
        'g_final': gain(ks[22], (D_MODEL,)),
    }


def reference(x, p, g_mix, w_in, lambda_q1, lambda_k1, lambda_q2, lambda_k2, g_sb_out,
              g_df_out, w_out, g_ffn, w_router_group, b_router_group, w_router_expert,
              b_router_expert, w_expert_gate, w_expert_up, w_expert_down, g_ple,
              w_ple_gate, w_ple_proj, g_final):
    for i in range(DEPTH):
        x = _hybrid_layer(x, p[i], i, g_mix[i], w_in[i], lambda_q1[i], lambda_k1[i],
                          lambda_q2[i], lambda_k2[i], g_sb_out[i], g_df_out[i], w_out[i],
                          g_ffn[i], w_router_group[i], b_router_group[i],
                          w_router_expert[i], b_router_expert[i], w_expert_gate[i],
                          w_expert_up[i], w_expert_down[i], g_ple[i], w_ple_gate[i],
                          w_ple_proj[i])
    return _rmsnorm(x, g_final)
```

```cpp
#include <hip/hip_runtime.h>
#include <hip/hip_bf16.h>
#include <cstdio>
#include <cstdint>

#ifndef MK_N_LAUNCHES
#define MK_N_LAUNCHES 1
#endif

#define LAS __attribute__((address_space(3)))
#define GAS __attribute__((address_space(1)))
typedef unsigned short bf16_t;
typedef short bf16x8 __attribute__((ext_vector_type(8)));
typedef short s16x4 __attribute__((ext_vector_type(4)));
typedef float f32x4 __attribute__((ext_vector_type(4)));
typedef float f32x2 __attribute__((ext_vector_type(2)));
typedef float f32x16 __attribute__((ext_vector_type(16)));
typedef unsigned u32x4 __attribute__((ext_vector_type(4)));
typedef unsigned u32x2 __attribute__((ext_vector_type(2)));

constexpr int BATCH = 8, SEQ = 4096, DM = 1024, NTOK = BATCH * SEQ;
constexpr int NQKV = 3072;
constexpr int COL_QSB = 0, COL_KSB = 512, COL_VSB = 1024, COL_QDF = 1536, COL_KDF = 2048, COL_VDF = 2560;
constexpr int NEXP = 16, DEXP = 512, PLE = 256;
constexpr float EPS = 1e-6f;
constexpr float LOG2E = 1.4426950408889634f;
constexpr float C2 = 0.125f * LOG2E;
constexpr float LAMBDA_INIT = 0.2f;
constexpr int LIST_CAP = NTOK;
constexpr int HID_ROWS = 2 * NTOK + NEXP * 256;

constexpr size_t MiB = 1u << 20;
constexpr size_t WS_CTL = 0, CTL_ZERO_BYTES = 1 * MiB;
constexpr size_t WS_WIN = 1 * MiB;
constexpr size_t WS_WOUT = 7 * MiB;
constexpr size_t WS_WGU = 9 * MiB;
constexpr size_t WS_WD = 41 * MiB;
constexpr size_t WS_WPG = 57 * MiB;
constexpr size_t WS_WPP = 59 * MiB;
constexpr size_t WS_LIST = 60 * MiB;
constexpr size_t WS_XN = 64 * MiB;
constexpr size_t WS_PB = 128 * MiB;
constexpr size_t WS_QKV = 144 * MiB;
constexpr size_t WS_HID = 144 * MiB;
constexpr size_t WS_PP = 212 * MiB;
constexpr size_t WS_OB = 336 * MiB;
constexpr size_t WS_YB = 336 * MiB;
constexpr size_t WS_END = 464 * MiB;
static_assert(WS_HID + (size_t)HID_ROWS * DEXP * 2 <= WS_PP && WS_PP + (size_t)NTOK * DM * 2 <= WS_QKV + (size_t)NTOK * NQKV * 2, "overlay map");
constexpr int CW_TMO = 0, CW_CODE = 1;
constexpr int CW_BAR = 4096;
constexpr int CW_CNT = 8192;

constexpr int RING_BYTES = 131072;
constexpr int LDSCTL_OFF = RING_BYTES, MISC_OFF = LDSCTL_OFF + 320;
constexpr int LDS_BYTES = 147456;
constexpr int NWAVES = 8;

#define RLX_AGENT __ATOMIC_RELAXED, __HIP_MEMORY_SCOPE_AGENT
#define LDS_WAIT() asm volatile("s_waitcnt lgkmcnt(0)" ::: "memory")
#define VM_WAIT() asm volatile("s_waitcnt vmcnt(0)" ::: "memory")
__device__ __forceinline__ unsigned cvt_pk_bf16(float lo, float hi) { unsigned r; asm volatile("v_cvt_pk_bf16_f32 %0, %1, %2" : "=v"(r) : "v"(lo), "v"(hi)); return r; }
__device__ __forceinline__ float bf_lo(unsigned u) { return __uint_as_float(u << 16); }
__device__ __forceinline__ float bf_hi(unsigned u) { return __uint_as_float(u & 0xffff0000u); }
__device__ __forceinline__ float wave_sum(float v) {
#pragma unroll
    for (int o = 1; o < 64; o <<= 1) v += __shfl_xor(v, o);
    return v;
}
__device__ __forceinline__ int fresh_lane() { int l; asm volatile("v_mbcnt_lo_u32_b32 %0, -1, 0\n\tv_mbcnt_hi_u32_b32 %0, -1, %0" : "=v"(l)); return l; }
__device__ __forceinline__ int fresh_wave() { return __builtin_amdgcn_readfirstlane((int)threadIdx.x >> 6); }
__device__ __forceinline__ float fast_rcp(float x) { return __builtin_amdgcn_rcpf(x); }
__device__ __forceinline__ float fast_exp2(float x) { return __builtin_amdgcn_exp2f(x); }
__device__ __forceinline__ float fast_log2(float x) { return __builtin_amdgcn_logf(x); }
__device__ __forceinline__ float sigmoidf_(float x) { return fast_rcp(1.0f + fast_exp2(-x * LOG2E)); }

namespace pg8 {
constexpr int BM = 256, BK = 64, HALF = 128, HTB = HALF * BK * 2, STAGE_BYTES = 8 * HTB, NXCD = 8, WGM = 8;
__host__ __device__ __forceinline__ int lds_byte(int r, int c) { const int st = (r >> 4) * 2 + (c >> 5), rr = r & 15, cc = c & 31, ob = rr * 64 + cc * 2; return st * 1024 + (ob ^ (((ob >> 9) & 1) << 5)); }
__host__ __device__ __forceinline__ void stage_rc(int b, int& R, int& C) { const int st = b / 1024, sb = b % 1024, swz = sb ^ (((sb >> 9) & 1) << 5); R = (st >> 1) * 16 + swz / 64; C = (st & 1) * 32 + (swz % 64) / 2; }
__host__ __device__ __forceinline__ int perm32(int rho) { const int n = rho >> 4, i = rho & 15; return 8 * (i >> 2) + 4 * n + (i & 3); }

struct Unit { int pm, pn, arow, brow, e, valid, lrow; };
struct Gemm { const bf16_t* A; const bf16_t* Bt; int K; const int* gidx; int gcap; };

struct StaticOrder {
    int nM, nN, nwg, G, c;
    __device__ void init(int M, int N, int G_, int c_) { nM = M / BM; nN = N / BM; nwg = nM * nN; G = G_; c = c_; }
    __device__ bool next(int i, Unit& u) const {
        const long L = (long)i * G + c; if (L >= nwg) return false;
        int wgid = (int)L; { const int q = nwg / NXCD, r = nwg % NXCD, xcd = wgid % NXCD, off = wgid / NXCD; wgid = (xcd < r ? xcd * (q + 1) : r * (q + 1) + (xcd - r) * q) + off; }
        const int nig = WGM * nN, gid = wgid / nig, fm = gid * WGM, gsz = (nM - fm) < WGM ? (nM - fm) : WGM;
        u.pm = fm + ((wgid % nig) % gsz); u.pn = (wgid % nig) / gsz; u.arow = u.pm * BM; u.brow = u.pn * BM; u.e = 0; u.valid = BM; u.lrow = 0; return true;
    }
};
struct GroupedOrder {
    int cnt[NEXP]; int nwg, G, c; int listmode;
    int nbrow;
    __device__ void init(const unsigned* gcnt, int G_, int c_, int listmode_, int nbrow_) {
        int tot = 0;
#pragma unroll
        for (int e = 0; e < NEXP; ++e) { cnt[e] = (int)__builtin_amdgcn_readfirstlane(__hip_atomic_load(gcnt + 64 * e, RLX_AGENT)); tot += (cnt[e] + 255) >> 8; }
        nwg = tot * 4; G = G_; c = c_; listmode = listmode_; nbrow = nbrow_;
    }
    __device__ bool next(int i, Unit& u) const {
        const long L = (long)i * G + c; if (L >= nwg) return false;
        int wgid = (int)L; { const int q = nwg / NXCD, r = nwg % NXCD, xcd = wgid % NXCD, off = wgid / NXCD; wgid = (xcd < r ? xcd * (q + 1) : r * (q + 1) + (xcd - r) * q) + off; }
        int tile = wgid >> 2; const int pn = wgid & 3;
        int e = 0, hoff = 0, found = 0, mt = 0, hh = 0, ce = 0;
#pragma unroll
        for (int k = 0; k < NEXP; ++k) { const int tl = (cnt[k] + 255) >> 8; if (!found) { if (tile < tl) { found = 1; e = k; mt = tile; hh = hoff; ce = cnt[k]; } else { tile -= tl; hoff += tl; } } }
        u.e = e; u.pn = pn; u.pm = hh + mt;
        u.lrow = e * LIST_CAP + mt * BM;
        u.arow = listmode ? u.lrow : (hh + mt) * BM;
        u.brow = e * nbrow + pn * BM;
        const int rem = ce - mt * BM; u.valid = rem < BM ? rem : BM;
        return true;
    }
};

template <class Epi, class Sched, bool GATHER>
__device__ __forceinline__ void gemm_phase(LAS unsigned char* lds, const Gemm g, const Sched& S, const Epi& E) {
    const int wid = fresh_wave(), lane = fresh_lane(), tid = wid * 64 + lane, wr = wid >> 2, wc = wid & 3, fr = lane & 15, fq = lane >> 4;
    const int K = g.K, nt = K / BK;
    unsigned voffA[2], voffB[2]; int RA[2], CA;
#pragma unroll
    for (int i = 0; i < 2; ++i) { int R, C; stage_rc(tid * 16 + i * 8192, R, C); const int Rb = Epi::PERM ? ((R & ~31) + perm32(R & 31)) : R;
        voffA[i] = (unsigned)(R * K + C) * 2u; voffB[i] = (unsigned)(Rb * K + C) * 2u; RA[i] = R; CA = C; }
    const size_t kstep = (size_t)(BK * 2);
    const size_t hstep = (size_t)HALF * K * 2;
    const unsigned ldsw = (unsigned)wid * 1024u;
    const int aoff = lds_byte(wr * 64 + fr, fq * 8), boff = lds_byte(wc * 32 + fr, fq * 8);
#define PG8_SA(b, h) (((b) * 2 + (h)) * HTB)
#define PG8_SB(b, h) ((4 + (b) * 2 + (h)) * HTB)
#define PG8_STAGE(bufoff, gbase, voff) do { _Pragma("unroll") for (int _i = 0; _i < 2; ++_i) \
        __builtin_amdgcn_global_load_lds((const unsigned*)((const char*)(gbase) + (voff)[_i]), (LAS unsigned*)(lds + (bufoff) + ldsw + _i * 8192), 16, 0, 0); } while (0)
#define PG8_STAGE2(bufoff, gbase, v0, v1) do { \
        __builtin_amdgcn_global_load_lds((const unsigned*)((const char*)(gbase) + (v0)), (LAS unsigned*)(lds + (bufoff) + ldsw), 16, 0, 0); \
        __builtin_amdgcn_global_load_lds((const unsigned*)((const char*)(gbase) + (v1)), (LAS unsigned*)(lds + (bufoff) + ldsw + 8192), 16, 0, 0); } while (0)
#define PG8_LDA(dst, b, h) do { _Pragma("unroll") for (int m = 0; m < 4; ++m) _Pragma("unroll") for (int k = 0; k < 2; ++k) dst[m][k] = *(const LAS bf16x8*)(lds + PG8_SA(b, h) + aoff + m * 2048 + k * 1024); } while (0)
#define PG8_LDB(dst, b, h) do { _Pragma("unroll") for (int n = 0; n < 2; ++n) _Pragma("unroll") for (int k = 0; k < 2; ++k) dst[n][k] = *(const LAS bf16x8*)(lds + PG8_SB(b, h) + boff + n * 2048 + k * 1024); } while (0)
#define PG8_MMA(ai, bj, At, Bt) do { __builtin_amdgcn_s_setprio(1); _Pragma("unroll") for (int m = 0; m < 4; ++m) _Pragma("unroll") for (int n = 0; n < 2; ++n) _Pragma("unroll") for (int k = 0; k < 2; ++k) \
        acc[ai][bj][m][n] = __builtin_amdgcn_mfma_f32_16x16x32_bf16(Bt[n][k], At[m][k], acc[ai][bj][m][n], 0, 0, 0); __builtin_amdgcn_s_setprio(0); } while (0)
#define PG8_WAIT_V(n) asm volatile("s_waitcnt vmcnt(" #n ")" ::: "memory")
#define PG8_WAIT_L(n) asm volatile("s_waitcnt lgkmcnt(" #n ")" ::: "memory")
#define PG8_BAR __builtin_amdgcn_s_barrier()
#define PG8_SCHED __builtin_amdgcn_sched_barrier(0)
#define PG8_GOFF(dst, u) do { _Pragma("unroll") for (int _h = 0; _h < 2; ++_h) _Pragma("unroll") for (int _i = 0; _i < 2; ++_i) { const int _r = _h * HALF + RA[_i]; int _tok = 0; \
        if (_r < (u).valid) _tok = g.gidx[2 * ((u).arow + _r)] >> 1; dst[_h][_i] = (unsigned)(_tok * K + CA) * 2u; } } while (0)
    Unit cur, nxt; int ui = 0;
    if (!S.next(0, cur)) return;
    f32x4 acc[2][2][4][2];
#pragma unroll
    for (int a = 0; a < 2; ++a)
#pragma unroll
        for (int b = 0; b < 2; ++b)
#pragma unroll
            for (int m = 0; m < 4; ++m)
#pragma unroll
                for (int n = 0; n < 2; ++n) acc[a][b][m][n] = (f32x4){0.f, 0.f, 0.f, 0.f};
    bf16x8 At[4][2], B0[2][2], B1[2][2];
    unsigned gc[2][2], gn[2][2];
    const char* cA; const char* cB = (const char*)g.Bt + (size_t)cur.brow * K * 2;
    if constexpr (GATHER) { cA = (const char*)g.A; PG8_GOFF(gc, cur); } else { cA = (const char*)g.A + (size_t)cur.arow * K * 2; }
#define PG8_STA(bufoff, ab, ko, go, h) do { if constexpr (GATHER) { PG8_STAGE2(bufoff, (ab) + (ko), go[h][0], go[h][1]); } else { PG8_STAGE(bufoff, (ab) + (ko) + (h) * hstep, voffA); } } while (0)
    PG8_STAGE(PG8_SB(0, 0), cB, voffB); PG8_STAGE(PG8_SB(0, 1), cB + hstep, voffB); PG8_STA(PG8_SA(0, 0), cA, 0, gc, 0); PG8_STA(PG8_SA(0, 1), cA, 0, gc, 1);
    if (wr == 1) PG8_BAR;
    PG8_WAIT_V(2); PG8_BAR;
    PG8_STAGE(PG8_SB(1, 0), cB + kstep, voffB); PG8_STA(PG8_SA(1, 0), cA, kstep, gc, 0); PG8_STAGE(PG8_SB(1, 1), cB + hstep + kstep, voffB);
    PG8_WAIT_V(6); PG8_BAR;
    for (;;) {
        const bool has_next = S.next(ui + 1, nxt);
        const char* nA; const char* nB = has_next ? (const char*)g.Bt + (size_t)nxt.brow * K * 2 : cB;
        if constexpr (GATHER) { nA = cA; if (has_next) { PG8_GOFF(gn, nxt); } else {
#pragma unroll
            for (int h = 0; h < 2; ++h)
#pragma unroll
                for (int i = 0; i < 2; ++i) gn[h][i] = gc[h][i]; } }
        else { nA = has_next ? (const char*)g.A + (size_t)nxt.arow * K * 2 : cA; }
        for (int t = 0; t < nt; t += 2) {
            const bool last = (t == nt - 2);
            const size_t k1 = (size_t)(t + 1) * kstep;
            const char* a2 = last ? nA : cA; const size_t k2 = last ? 0 : (size_t)(t + 2) * kstep; const char* b2 = last ? nB : cB + (size_t)(t + 2) * kstep;
            const char* b3 = b2 + kstep; const size_t k3 = k2 + kstep;
            unsigned g2[2][2];
            if constexpr (GATHER) {
#pragma unroll
                for (int h = 0; h < 2; ++h)
#pragma unroll
                    for (int i = 0; i < 2; ++i) g2[h][i] = last ? gn[h][i] : gc[h][i]; }
            PG8_LDB(B0, 0, 0); PG8_LDB(B1, 0, 1); PG8_SCHED; PG8_LDA(At, 0, 0); PG8_STA(PG8_SA(1, 1), cA, k1, gc, 1);
            PG8_WAIT_V(8); PG8_WAIT_L(0); PG8_BAR; PG8_MMA(0, 0, At, B0); PG8_MMA(0, 1, At, B1); PG8_BAR; PG8_SCHED;
            PG8_LDA(At, 0, 1); PG8_STAGE(PG8_SB(0, 0), b2, voffB); PG8_STAGE(PG8_SB(0, 1), b2 + hstep, voffB); PG8_STA(PG8_SA(0, 0), a2, k2, g2, 0);
            PG8_WAIT_V(8); PG8_WAIT_L(0); PG8_BAR; PG8_MMA(1, 0, At, B0); PG8_MMA(1, 1, At, B1); PG8_BAR; PG8_SCHED;
            PG8_LDB(B0, 1, 0); PG8_LDB(B1, 1, 1); PG8_SCHED; PG8_LDA(At, 1, 0); PG8_STA(PG8_SA(0, 1), a2, k2, g2, 1);
            PG8_WAIT_V(8); PG8_WAIT_L(0); PG8_BAR; PG8_MMA(0, 0, At, B0); PG8_MMA(0, 1, At, B1); PG8_BAR; PG8_SCHED;
            PG8_LDA(At, 1, 1); PG8_STAGE(PG8_SB(1, 0), b3, voffB); PG8_STAGE(PG8_SB(1, 1), b3 + hstep, voffB); PG8_STA(PG8_SA(1, 0), a2, k3, g2, 0);
            PG8_WAIT_V(8); PG8_WAIT_L(0); PG8_BAR; PG8_MMA(1, 0, At, B0); PG8_MMA(1, 1, At, B1); PG8_BAR; PG8_SCHED;
        }
        if (wr == 0) PG8_BAR;
        E(acc, cur, wr, wc, fr, fq);
        if (!has_next) break;
#pragma unroll
        for (int a = 0; a < 2; ++a)
#pragma unroll
            for (int b = 0; b < 2; ++b)
#pragma unroll
                for (int m = 0; m < 4; ++m)
#pragma unroll
                    for (int n = 0; n < 2; ++n) acc[a][b][m][n] = (f32x4){0.f, 0.f, 0.f, 0.f};
        cur = nxt; cA = nA; cB = nB; ++ui;
        if constexpr (GATHER) {
#pragma unroll
            for (int h = 0; h < 2; ++h)
#pragma unroll
                for (int i = 0; i < 2; ++i) gc[h][i] = gn[h][i]; }
        if (wr == 1) PG8_BAR;
    }
    PG8_WAIT_V(0);
    PG8_BAR;
#undef PG8_SA
#undef PG8_SB
#undef PG8_STAGE
#undef PG8_STAGE2
#undef PG8_STA
#undef PG8_GOFF
#undef PG8_LDA
#undef PG8_LDB
#undef PG8_MMA
#undef PG8_WAIT_V
#undef PG8_WAIT_L
#undef PG8_BAR
#undef PG8_SCHED
}

struct EpiQKV {
    static constexpr bool PERM = true;
    bf16_t* O;
    __device__ __forceinline__ void operator()(const f32x4 (&acc)[2][2][4][2], const Unit& u, int wr, int wc, int fr, int fq) const {
        const int row0 = u.pm * BM + wr * 64 + fr, col0 = u.pn * BM + wc * 32 + 8 * fq;
        const float sc = (u.pn < 2 || (u.pn >= 6 && u.pn < 8)) ? C2 : 1.0f;
#pragma unroll
        for (int ai = 0; ai < 2; ++ai)
#pragma unroll
            for (int m = 0; m < 4; ++m) { bf16_t* rowp = O + (size_t)(row0 + ai * HALF + m * 16) * NQKV + col0;
#pragma unroll
                for (int bj = 0; bj < 2; ++bj) { const f32x4 v0 = acc[ai][bj][m][0] * sc, v1 = acc[ai][bj][m][1] * sc;
                    u32x4 w; w.x = cvt_pk_bf16(v0[0], v0[1]); w.y = cvt_pk_bf16(v0[2], v0[3]); w.z = cvt_pk_bf16(v1[0], v1[1]); w.w = cvt_pk_bf16(v1[2], v1[3]);
                    *(u32x4*)(rowp + bj * HALF) = w; } }
    }
};
struct EpiBf16 {
    static constexpr bool PERM = true;
    bf16_t* O; int ldc;
    __device__ __forceinline__ void operator()(const f32x4 (&acc)[2][2][4][2], const Unit& u, int wr, int wc, int fr, int fq) const {
        const int row0 = u.pm * BM + wr * 64 + fr, col0 = u.pn * BM + wc * 32 + 8 * fq;
#pragma unroll
        for (int ai = 0; ai < 2; ++ai)
#pragma unroll
            for (int m = 0; m < 4; ++m) { bf16_t* rowp = O + (size_t)(row0 + ai * HALF + m * 16) * ldc + col0;
#pragma unroll
                for (int bj = 0; bj < 2; ++bj) { const f32x4 v0 = acc[ai][bj][m][0], v1 = acc[ai][bj][m][1];
                    u32x4 w; w.x = cvt_pk_bf16(v0[0], v0[1]); w.y = cvt_pk_bf16(v0[2], v0[3]); w.z = cvt_pk_bf16(v1[0], v1[1]); w.w = cvt_pk_bf16(v1[2], v1[3]);
                    *(u32x4*)(rowp + bj * HALF) = w; } }
    }
};
struct EpiResF32 {
    static constexpr bool PERM = false;
    const float* base; float* out;
    __device__ __forceinline__ void operator()(const f32x4 (&acc)[2][2][4][2], const Unit& u, int wr, int wc, int fr, int fq) const {
        const int row0 = u.pm * BM + wr * 64 + fr, col0 = u.pn * BM + wc * 32 + 4 * fq;
#pragma unroll
        for (int ai = 0; ai < 2; ++ai)
#pragma unroll
            for (int m = 0; m < 4; ++m) { const size_t off = (size_t)(row0 + ai * HALF + m * 16) * DM + col0;
#pragma unroll
                for (int bj = 0; bj < 2; ++bj)
#pragma unroll
                    for (int n = 0; n < 2; ++n) { const f32x4 b = *(const f32x4*)(base + off + bj * HALF + n * 16); *(f32x4*)(out + off + bj * HALF + n * 16) = b + acc[ai][bj][m][n]; } }
    }
};
struct EpiSwiGLU {
    static constexpr bool PERM = true;
    bf16_t* O;
    __device__ __forceinline__ void operator()(const f32x4 (&acc)[2][2][4][2], const Unit& u, int wr, int wc, int fr, int fq) const {
        const int row0 = u.pm * BM + wr * 64 + fr, col0 = u.pn * HALF + wc * 32 + 8 * fq;
#pragma unroll
        for (int ai = 0; ai < 2; ++ai)
#pragma unroll
            for (int m = 0; m < 4; ++m) { bf16_t* rowp = O + (size_t)(row0 + ai * HALF + m * 16) * DEXP + col0;
                float h[8];
#pragma unroll
                for (int n = 0; n < 2; ++n)
#pragma unroll
                    for (int j = 0; j < 4; ++j) { const float gt = acc[ai][0][m][n][j], up = acc[ai][1][m][n][j]; h[4 * n + j] = gt * sigmoidf_(gt) * up; }
                u32x4 w; w.x = cvt_pk_bf16(h[0], h[1]); w.y = cvt_pk_bf16(h[2], h[3]); w.z = cvt_pk_bf16(h[4], h[5]); w.w = cvt_pk_bf16(h[6], h[7]);
                *(u32x4*)rowp = w; }
    }
};
struct EpiDown {
    static constexpr bool PERM = true;
    bf16_t* O; const int* list;
    __device__ __forceinline__ void operator()(const f32x4 (&acc)[2][2][4][2], const Unit& u, int wr, int wc, int fr, int fq) const {
        const int r0 = wr * 64 + fr, col0 = u.pn * BM + wc * 32 + 8 * fq;
#pragma unroll
        for (int ai = 0; ai < 2; ++ai)
#pragma unroll
            for (int m = 0; m < 4; ++m) { const int r = r0 + ai * HALF + m * 16;
                if (r < u.valid) { const int2 ent = *(const int2*)(list + 2 * (size_t)(u.lrow + r)); const float w = __int_as_float(ent.y);
                    bf16_t* rowp = O + (size_t)ent.x * DM + col0;
#pragma unroll
                    for (int bj = 0; bj < 2; ++bj) { const f32x4 v0 = acc[ai][bj][m][0] * w, v1 = acc[ai][bj][m][1] * w;
                        u32x4 q; q.x = cvt_pk_bf16(v0[0], v0[1]); q.y = cvt_pk_bf16(v0[2], v0[3]); q.z = cvt_pk_bf16(v1[0], v1[1]); q.w = cvt_pk_bf16(v1[2], v1[3]);
                        *(u32x4*)(rowp + bj * HALF) = q; } } }
    }
};
struct EpiPle {
    static constexpr bool PERM = false;
    float* X; const bf16_t* PP;
    __device__ __forceinline__ void operator()(const f32x4 (&acc)[2][2][4][2], const Unit& u, int wr, int wc, int fr, int fq) const {
        const int row0 = u.pm * BM + wr * 64 + fr, col0 = u.pn * BM + wc * 32 + 4 * fq;
#pragma unroll
        for (int ai = 0; ai < 2; ++ai)
#pragma unroll
            for (int m = 0; m < 4; ++m) { const size_t off = (size_t)(row0 + ai * HALF + m * 16) * DM + col0;
#pragma unroll
                for (int bj = 0; bj < 2; ++bj)
#pragma unroll
                    for (int n = 0; n < 2; ++n) { const size_t o2 = off + bj * HALF + n * 16; const f32x4 b = *(const f32x4*)(X + o2); const u32x2 pw = *(const u32x2*)(PP + o2); const f32x4 a = acc[ai][bj][m][n];
                        f32x4 r; r[0] = b[0] + sigmoidf_(a[0]) * bf_lo(pw.x); r[1] = b[1] + sigmoidf_(a[1]) * bf_hi(pw.x); r[2] = b[2] + sigmoidf_(a[2]) * bf_lo(pw.y); r[3] = b[3] + sigmoidf_(a[3]) * bf_hi(pw.y);
                        *(f32x4*)(X + o2) = r; } }
    }
};
}

namespace att {
typedef __attribute__((address_space(3))) const char* lds_cptr;
typedef short v4i16_t __attribute__((ext_vector_type(4)));
__device__ __forceinline__ int crow(int r, int hi) { return (r & 3) + 8 * (r >> 2) + 4 * hi; }
__device__ __forceinline__ void glds16(const void* gsrc, unsigned lds_dst) { unsigned keep;
    asm volatile("s_mov_b32 %0, m0\n\ts_mov_b32 m0, %2\n\ts_nop 0\n\tglobal_load_lds_dwordx4 %1, off\n\ts_mov_b32 m0, %0" : "=&s"(keep) : "v"(gsrc), "s"(lds_dst) : "memory"); }
__device__ __forceinline__ s16x4 vtr(lds_cptr p) { return __builtin_bit_cast(s16x4, __builtin_amdgcn_ds_read_tr16_b64_v4i16((__attribute__((address_space(3))) v4i16_t*)p)); }
__device__ __forceinline__ float swap_sum(float v) { auto rr = __builtin_amdgcn_permlane32_swap(__float_as_uint(v), __float_as_uint(v), false, false); return __uint_as_float(rr[0]) + __uint_as_float(rr[1]); }
__device__ __forceinline__ float swap_max(float v) { auto rr = __builtin_amdgcn_permlane32_swap(__float_as_uint(v), __float_as_uint(v), false, false); return fmaxf(__uint_as_float(rr[0]), __uint_as_float(rr[1])); }
#define ATT_MFMA(A, B, C) __builtin_amdgcn_mfma_f32_32x32x16_bf16((A), (B), (C), 0, 0, 0)
#define ATT_VFRAG(p) ({ const s16x4 _lo = vtr(p); const s16x4 _hi = vtr((p) + 512); (bf16x8){_lo[0], _lo[1], _lo[2], _lo[3], _hi[0], _hi[1], _hi[2], _hi[3]}; })

__device__ __forceinline__ void sb_unit(int b, int qi, int parity, const bf16_t* __restrict__ QKV, bf16_t* __restrict__ OB, char* shm) {
    const int lane = fresh_lane(), r32 = lane & 31, hi = lane >> 5; const int wid = fresh_wave();
    const long rowbase = (long)b * SEQ; const int t0 = qi * 32, h = wid;
    const bf16_t* Qp = QKV + (rowbase + t0 + r32) * NQKV + COL_QSB + h * 64 + hi * 8;
    bf16x8 qr[4];
#pragma unroll
    for (int d0 = 0; d0 < 4; ++d0) qr[d0] = *(const bf16x8*)(Qp + 16 * d0);
    const bf16_t* Kh = QKV + rowbase * NQKV + COL_KSB + h * 64;
    const bf16_t* Vh = QKV + rowbase * NQKV + COL_VSB + h * 64;
    char* vimg = shm + 8192 * wid;
    const lds_cptr vp0 = (lds_cptr)vimg + ((lane >> 4) & 1) * 32 + (lane & 3) * 8 + (4 * hi + ((lane & 15) >> 2)) * 64;
    f32x16 o0 = {}, o1 = {};
    float R = 0.f;
    const int jd = qi >> 1, tq = t0 + r32;
    for (int j = jd; j >= 0; --j) {
        const int kb = 64 * j;
        u32x4 vv[8];
#pragma unroll
        for (int it = 0; it < 8; ++it) vv[it] = *(const u32x4*)(Vh + (long)(kb + 8 * it + (lane >> 3)) * NQKV + (lane & 7) * 8);
        f32x16 p0 = {}, p1 = {};
#pragma unroll
        for (int d0 = 0; d0 < 4; ++d0) {
            const bf16x8 k0 = *(const bf16x8*)(Kh + (long)(kb + r32) * NQKV + 16 * d0 + 8 * hi);
            const bf16x8 k1 = *(const bf16x8*)(Kh + (long)(kb + 32 + r32) * NQKV + 16 * d0 + 8 * hi);
            p0 = ATT_MFMA(k0, qr[d0], p0); p1 = ATT_MFMA(k1, qr[d0], p1);
        }
#pragma unroll
        for (int it = 0; it < 8; ++it) *(u32x4*)(vimg + ((lane & 7) >> 2) * 4096 + (8 * it + (lane >> 3)) * 64 + (lane & 3) * 16) = vv[it];
        float lk[32], lb[32];
#pragma unroll
        for (int r = 0; r < 32; ++r) { const float z = (r < 16) ? p0[r & 15] : p1[r & 15];
            const float sp = fmaxf(z, 0.f) + fast_log2(1.0f + fast_exp2(-fabsf(z)));
            lk[r] = -sp; lb[r] = z - sp; }
        if (j == jd) {
#pragma unroll
            for (int r = 0; r < 32; ++r) { const int key = kb + crow(r & 15, hi) + (r >> 4) * 32; if (key >= tq) { lk[r] = 0.f; lb[r] = -INFINITY; } }
        }
        float lo[8], hv[8];
#pragma unroll
        for (int i = 0; i < 8; ++i) { const float gs = (lk[4 * i] + lk[4 * i + 1]) + (lk[4 * i + 2] + lk[4 * i + 3]);
            auto rr = __builtin_amdgcn_permlane32_swap(__float_as_uint(gs), __float_as_uint(gs), false, false); lo[i] = __uint_as_float(rr[0]); hv[i] = __uint_as_float(rr[1]); }
        float T = 0.f;
        float w[32];
#pragma unroll
        for (int i = 7; i >= 0; --i) {
            const float E = R + T + (hi == 0 ? hv[i] : 0.f);
            const float c3 = E, c2 = c3 + lk[4 * i + 3], c1 = c2 + lk[4 * i + 2], c0 = c1 + lk[4 * i + 1];
            w[4 * i + 3] = fast_exp2(lb[4 * i + 3] + c3); w[4 * i + 2] = fast_exp2(lb[4 * i + 2] + c2); w[4 * i + 1] = fast_exp2(lb[4 * i + 1] + c1); w[4 * i] = fast_exp2(lb[4 * i] + c0);
            T += lo[i] + hv[i];
        }
        R += T;
        u32x4 pw[4];
#pragma unroll
        for (int s = 0; s < 4; ++s) { pw[s].x = cvt_pk_bf16(w[8 * s], w[8 * s + 1]); pw[s].y = cvt_pk_bf16(w[8 * s + 2], w[8 * s + 3]); pw[s].z = cvt_pk_bf16(w[8 * s + 4], w[8 * s + 5]); pw[s].w = cvt_pk_bf16(w[8 * s + 6], w[8 * s + 7]); }
#pragma unroll
        for (int s = 0; s < 4; ++s) {
            const bf16x8 v0 = ATT_VFRAG(vp0 + s * 1024), v1 = ATT_VFRAG(vp0 + 4096 + s * 1024);
            o0 = ATT_MFMA(v0, __builtin_bit_cast(bf16x8, pw[s]), o0); o1 = ATT_MFMA(v1, __builtin_bit_cast(bf16x8, pw[s]), o1);
        }
        if (__all(R < -152.0f)) break;
    }
    float ss = 0.f;
#pragma unroll
    for (int r = 0; r < 16; ++r) ss += o0[r] * o0[r] + o1[r] * o1[r];
    ss = swap_sum(ss);
    float* red = (float*)(shm + 65536) + parity * 256;
    if (hi == 0) red[wid * 32 + r32] = ss;
    __syncthreads();
    float tot = 0.f;
#pragma unroll
    for (int w8 = 0; w8 < 8; ++w8) tot += red[w8 * 32 + r32];
    const float rstd = 1.0f / sqrtf(tot * (1.0f / 512.0f) + EPS);
    bf16_t* Op = OB + (rowbase + t0 + r32) * DM + h * 64 + 4 * hi;
#pragma unroll
    for (int i = 0; i < 4; ++i) {
        u32x2 a; a.x = cvt_pk_bf16(o0[4 * i] * rstd, o0[4 * i + 1] * rstd); a.y = cvt_pk_bf16(o0[4 * i + 2] * rstd, o0[4 * i + 3] * rstd); *(u32x2*)(Op + 8 * i) = a;
        u32x2 c; c.x = cvt_pk_bf16(o1[4 * i] * rstd, o1[4 * i + 1] * rstd); c.y = cvt_pk_bf16(o1[4 * i + 2] * rstd, o1[4 * i + 3] * rstd); *(u32x2*)(Op + 32 + 8 * i) = c;
    }
}

constexpr int DF_SLOT = 32768, DF_THR = 8;
__device__ __forceinline__ void df_unit(int b, int h, int qb, const bf16_t* __restrict__ QKV, bf16_t* __restrict__ OB, char* shm, float lam, float slope2) {
    const int lane = fresh_lane(), r32 = lane & 31, hi = lane >> 5; const int wid = fresh_wave();
    const int c = wid & 1, qs = wid >> 1;
    const long rowbase = (long)b * SEQ; const int t0 = qb * 128, tq0 = t0 + 32 * qs, NT = 2 * qb + 2, jdw = 2 * qb + (qs >> 1);
    const bf16_t* Kg = QKV + rowbase * NQKV + COL_KDF + h * 128;
    const bf16_t* Vg = QKV + rowbase * NQKV + COL_VDF + h * 128;
    const unsigned lds0 = (unsigned)(uintptr_t)shm;
    const bf16_t* ksrc0 = Kg + (long)lane * NQKV + wid * 8;
    const bf16_t* ksrc1 = ksrc0 + 64;
    const bf16_t* vsrc0 = Vg + (long)(16 * (wid & 3) + (lane >> 2)) * NQKV + (wid >> 2) * 32 + (lane & 3) * 8;
    const bf16_t* vsrc1 = vsrc0 + 64;
#define DF_DMA(j, slot) do { const long _ro = (long)(j) * 64 * NQKV; const unsigned _d = (unsigned)__builtin_amdgcn_readfirstlane(lds0 + (slot) * DF_SLOT + wid * 1024); \
        glds16(ksrc0 + _ro, _d); glds16(ksrc1 + _ro, _d + 8192); glds16(vsrc0 + _ro, _d + 16384); glds16(vsrc1 + _ro, _d + 16384 + 8192); } while (0)
    DF_DMA(NT - 1, 0); DF_DMA(NT - 2, 1);
    const bf16_t* Qp = QKV + (rowbase + tq0 + r32) * NQKV + COL_QDF + h * 128 + c * 64 + hi * 8;
    bf16x8 qr[4];
#pragma unroll
    for (int d0 = 0; d0 < 4; ++d0) qr[d0] = *(const bf16x8*)(Qp + 16 * d0);
    f32x16 o[4]; o[0] = f32x16{}; o[1] = f32x16{}; o[2] = f32x16{}; o[3] = f32x16{};
    float mhat = 0.f, l = 0.f; bool first = true;
    const lds_cptr shm3 = (lds_cptr)shm;
    const int koff = (8 * c + hi) * 1024 + r32 * 16;
    const int voff = 16384 + ((lane >> 4) & 1) * 32 + (lane & 3) * 8 + (4 * hi + ((lane & 15) >> 2)) * 64;
    const int tq = tq0 + r32;
    int slot = 0;
    for (int st = 0; st < NT; ++st) {
        const int j = NT - 1 - st;
        if (st + 1 < NT) asm volatile("s_waitcnt vmcnt(4) lgkmcnt(0)\n\ts_barrier" ::: "memory"); else asm volatile("s_waitcnt vmcnt(0) lgkmcnt(0)\n\ts_barrier" ::: "memory");
        if (st + 2 < NT) { const int s2 = (slot + 2 >= 3) ? slot - 1 : slot + 2; DF_DMA(j - 2, s2); }
        if (j <= jdw) {
            const lds_cptr kp = shm3 + slot * DF_SLOT + koff; const lds_cptr vp = shm3 + slot * DF_SLOT + voff;
            const int kb = 64 * j;
            const float basev = slope2 * (float)(kb - tq0 + 4 * hi) - mhat;
            f32x16 p0, p1;
#pragma unroll
            for (int r = 0; r < 16; ++r) { p0[r] = basev + slope2 * (float)((r & 3) + 8 * (r >> 2)); p1[r] = p0[r] + slope2 * 32.0f; }
#pragma unroll
            for (int d0 = 0; d0 < 4; ++d0) {
                const bf16x8 k0 = *(const __attribute__((address_space(3))) bf16x8*)(kp + d0 * 2048);
                const bf16x8 k1 = *(const __attribute__((address_space(3))) bf16x8*)(kp + d0 * 2048 + 512);
                p0 = ATT_MFMA(k0, qr[d0], p0); p1 = ATT_MFMA(k1, qr[d0], p1);
            }
            if (j == jdw) {
#pragma unroll
                for (int r = 0; r < 16; ++r) { const int key = kb + crow(r, hi); if (key > tq) p0[r] = -INFINITY; if (key + 32 > tq) p1[r] = -INFINITY; }
            }
            float rm = fmaxf(p0[0], p1[0]);
#pragma unroll
            for (int r = 1; r < 16; ++r) rm = fmaxf(rm, fmaxf(p0[r], p1[r]));
            rm = swap_max(rm);
            if (first || __any(rm > (float)DF_THR)) {
                const float dl = first ? rm : fmaxf(rm, 0.f); mhat += dl;
#pragma unroll
                for (int r = 0; r < 16; ++r) { p0[r] -= dl; p1[r] -= dl; }
                const float f = fast_exp2(-dl); l *= f;
#pragma unroll
                for (int d = 0; d < 4; ++d)
#pragma unroll
                    for (int r = 0; r < 16; ++r) o[d][r] *= f;
                first = false;
            }
            float sacc = 0.f;
#pragma unroll
            for (int r = 0; r < 16; ++r) { p0[r] = fast_exp2(p0[r]); p1[r] = fast_exp2(p1[r]); sacc += p0[r] + p1[r]; }
            l += sacc;
            u32x4 pw[4];
#pragma unroll
            for (int s = 0; s < 2; ++s) { pw[s].x = cvt_pk_bf16(p0[8 * s], p0[8 * s + 1]); pw[s].y = cvt_pk_bf16(p0[8 * s + 2], p0[8 * s + 3]); pw[s].z = cvt_pk_bf16(p0[8 * s + 4], p0[8 * s + 5]); pw[s].w = cvt_pk_bf16(p0[8 * s + 6], p0[8 * s + 7]);
                pw[2 + s].x = cvt_pk_bf16(p1[8 * s], p1[8 * s + 1]); pw[2 + s].y = cvt_pk_bf16(p1[8 * s + 2], p1[8 * s + 3]); pw[2 + s].z = cvt_pk_bf16(p1[8 * s + 4], p1[8 * s + 5]); pw[2 + s].w = cvt_pk_bf16(p1[8 * s + 6], p1[8 * s + 7]); }
#pragma unroll
            for (int s = 0; s < 4; ++s)
#pragma unroll
                for (int d = 0; d < 4; ++d) { const bf16x8 vf = ATT_VFRAG(vp + d * 4096 + s * 1024); o[d] = ATT_MFMA(vf, __builtin_bit_cast(bf16x8, pw[s]), o[d]); }
        }
        slot = (slot == 2) ? 0 : slot + 1;
    }
#undef DF_DMA
    asm volatile("s_waitcnt vmcnt(0) lgkmcnt(0)\n\ts_barrier" ::: "memory");
    l = swap_sum(l);
    const float inv = 1.0f / l;
    float* xch = (float*)shm + qs * 4096;
    if (c == 1) {
        const float sc = inv * lam;
#pragma unroll
        for (int d = 0; d < 4; ++d)
#pragma unroll
            for (int r = 0; r < 16; ++r) xch[(d * 16 + r) * 64 + lane] = o[d][r] * sc;
    }
    __syncthreads();
    if (c == 0) {
        float ss = 0.f;
#pragma unroll
        for (int d = 0; d < 4; ++d)
#pragma unroll
            for (int r = 0; r < 16; ++r) { const float v = o[d][r] * inv - xch[(d * 16 + r) * 64 + lane]; o[d][r] = v; ss += v * v; }
        ss = swap_sum(ss);
        const float rstd = 1.0f / sqrtf(ss * (1.0f / 128.0f) + EPS);
        bf16_t* Op = OB + (rowbase + tq0 + r32) * DM + 512 + h * 128 + 4 * hi;
#pragma unroll
        for (int d = 0; d < 4; ++d)
#pragma unroll
            for (int i = 0; i < 4; ++i) { u32x2 a; a.x = cvt_pk_bf16(o[d][4 * i] * rstd, o[d][4 * i + 1] * rstd); a.y = cvt_pk_bf16(o[d][4 * i + 2] * rstd, o[d][4 * i + 3] * rstd); *(u32x2*)(Op + d * 32 + 8 * i) = a; }
    }
    __syncthreads();
}
}

#define XB_TMO      128
#define XB_XCNT(j)  (256  + 64 * (j))
#define XB_XSUB(j)  (1280 + 64 * (j))
#define XB_XGEN(j)  (2304 + 64 * (j))
#define XB_TOP      3328
#define XB_TOPGEN   3392
#define XCD_BAR_WORDS 3456
#define XB_SPIN_CAP (1u << 18)
__device__ __forceinline__ unsigned xb_ld(unsigned* p)              { return __hip_atomic_load(p, __ATOMIC_RELAXED, __HIP_MEMORY_SCOPE_AGENT); }
__device__ __forceinline__ unsigned xb_add(unsigned* p, unsigned v) { return __hip_atomic_fetch_add(p, v, __ATOMIC_RELAXED, __HIP_MEMORY_SCOPE_AGENT); }
__device__ __forceinline__ unsigned xb_xcc_id() { return (unsigned)__builtin_amdgcn_s_getreg((3 << 11) | 20) & 0xFu; }
#define XB_SPIN(cond, bar) do { unsigned _sp = 0; while (cond) { __builtin_amdgcn_s_sleep(1); \
    if ((++_sp & 255u) == 0u) { if (xb_ld(&(bar)[XB_TMO])) break; if (_sp > XB_SPIN_CAP) { atomicAdd(&(bar)[XB_TMO], 1u); break; } } } } while (0)
struct XcdBarrier { unsigned* bar; unsigned x; volatile LAS unsigned* st; };
__device__ __forceinline__ XcdBarrier xcd_barrier_post(unsigned* bar, volatile LAS unsigned* st) {
    XcdBarrier b; b.bar = bar; b.x = xb_xcc_id(); b.st = st;
    if (threadIdx.x == 0) (void)xb_add(&bar[XB_XCNT(b.x)], 1u);
    return b;
}
__device__ __forceinline__ void xcd_barrier_complete(unsigned* bar, unsigned x, unsigned& nloc, unsigned& nx) {
    const unsigned G = gridDim.x * gridDim.y * gridDim.z;
    unsigned sum, cnt, mine, sp = 0u;
    for (;;) {
        sum = 0u; cnt = 0u; mine = 0u;
#pragma unroll
        for (unsigned j = 0; j < 16; ++j) { const unsigned c = xb_ld(&bar[XB_XCNT(j)]); sum += c; cnt += (c > 0u) ? 1u : 0u; mine = (j == x) ? c : mine; }
        if (sum == G) break;
        __builtin_amdgcn_s_sleep(1);
        if ((++sp & 255u) == 0u) { if (xb_ld(&bar[XB_TMO])) break; if (sp > XB_SPIN_CAP) { atomicAdd(&bar[XB_TMO], 1u); break; } }
    }
    nloc = mine > 0u ? mine : 1u; nx = cnt > 0u ? cnt : 1u;
}
__device__ __forceinline__ void xcd_barrier(const XcdBarrier& b) {
    asm volatile("s_waitcnt vmcnt(0)" ::: "memory");
    __syncthreads();
    if (threadIdx.x == 0) {
        unsigned* bar = b.bar;
        __builtin_amdgcn_s_waitcnt(0);
        unsigned nloc = b.st[0], nx = b.st[1];
        if (nloc == 0u) { xcd_barrier_complete(bar, b.x, nloc, nx); b.st[0] = nloc; b.st[1] = nx; }
        const unsigned old = xb_add(&bar[XB_XSUB(b.x)], 1u);
        const unsigned gen = old / nloc;
        if (old + 1u == (gen + 1u) * nloc) {
            __builtin_amdgcn_fence(__ATOMIC_RELEASE, "agent");
            asm volatile("s_waitcnt vmcnt(0)" ::: "memory");
            const unsigned og = xb_add(&bar[XB_TOP], 1u);
            const unsigned tg = og / nx;
            if (og + 1u == (tg + 1u) * nx) xb_add(&bar[XB_TOPGEN], 1u);
            else XB_SPIN(xb_ld(&bar[XB_TOPGEN]) == tg, bar);
            __builtin_amdgcn_fence(__ATOMIC_ACQUIRE, "agent");
            xb_add(&bar[XB_XGEN(b.x)], 1u);
            asm volatile("s_waitcnt vmcnt(0)" ::: "memory");
        } else {
            XB_SPIN(xb_ld(&bar[XB_XGEN(b.x)]) == gen, bar);
            __builtin_amdgcn_fence(__ATOMIC_ACQUIRE, "agent");
            asm volatile("s_waitcnt vmcnt(0)" ::: "memory");
        }
    }
    __syncthreads();
}

__device__ __forceinline__ unsigned pk2(float lo, float hi) { return cvt_pk_bf16(lo, hi); }
__device__ __forceinline__ void p0_transpose_item(const float* __restrict__ W, int K, int N, bf16_t* __restrict__ WT, int kb, int nb, int wtrow, LAS float* scr, int lane, int mode, const float* __restrict__ g0, const float* __restrict__ g1) {
    const int k0 = 64 * kb, n0 = 32 * nb;
#pragma unroll 8
    for (int i = 0; i < 32; ++i) { const int kk = 2 * i + (lane >> 5); float v = W[(size_t)(k0 + kk) * N + n0 + (lane & 31)];
        if (mode == 1) { const int k = k0 + kk; v *= (k < 512) ? g0[k] : g1[(k - 512) & 127] * (1.0f - LAMBDA_INIT); }
        else if (mode == 2) { v *= g0[k0 + kk]; }
        scr[kk * 33 + (lane & 31)] = v; }
    LDS_WAIT(); asm volatile("" ::: "memory");
    const int c = lane & 7;
#pragma unroll
    for (int j = 0; j < 4; ++j) { const int n = (lane >> 3) + 8 * j; const LAS float* s = scr + (8 * c) * 33 + n;
        u32x4 o; o.x = pk2(s[0 * 33], s[1 * 33]); o.y = pk2(s[2 * 33], s[3 * 33]); o.z = pk2(s[4 * 33], s[5 * 33]); o.w = pk2(s[6 * 33], s[7 * 33]);
        *(u32x4*)(WT + (size_t)(wtrow + n) * K + k0 + 8 * c) = o; }
    LDS_WAIT(); asm volatile("" ::: "memory");
}

struct Ptrs {
    const float *x, *p, *g_mix, *w_in, *lq1, *lk1, *lq2, *lk2, *g_sb, *g_df, *w_out, *g_ffn, *w_rg, *b_rg, *w_re, *b_re, *w_eg, *w_eu, *w_ed, *g_ple, *w_pg, *w_pp, *g_final;
    float* out; unsigned char* ws;
};

__device__ __forceinline__ void p0_prologue(const Ptrs& P, LAS unsigned char* lds, int gw, int NGW, int lane, int wave) {
    LAS float* scr = (LAS float*)(lds + wave * 16384);
    bf16_t* Win_t = (bf16_t*)(P.ws + WS_WIN); bf16_t* Wout_t = (bf16_t*)(P.ws + WS_WOUT); bf16_t* Wgu_t = (bf16_t*)(P.ws + WS_WGU); bf16_t* Wd_t = (bf16_t*)(P.ws + WS_WD);
    bf16_t* Wpg_t = (bf16_t*)(P.ws + WS_WPG); bf16_t* Wpp_t = (bf16_t*)(P.ws + WS_WPP);
    constexpr int I_IN = 16 * 96, I_OUT = 16 * 32, I_EG = NEXP * 16 * 16, I_ED = NEXP * 8 * 32, I_PG = 16 * 32, I_PP = 4 * 32;
    constexpr int NITEMS = I_IN + I_OUT + 2 * I_EG + I_ED + I_PG + I_PP;
    for (int it = gw; it < NITEMS; it += NGW) {
        int r = it;
        if (r < I_IN) { const int kb = r / 96, nb = r % 96; p0_transpose_item(P.w_in, 1024, 3072, Win_t, kb, nb, 32 * nb, scr, lane, 0, nullptr, nullptr); continue; } r -= I_IN;
        if (r < I_OUT) { const int kb = r / 32, nb = r % 32; p0_transpose_item(P.w_out, 1024, 1024, Wout_t, kb, nb, 32 * nb, scr, lane, 1, P.g_sb, P.g_df); continue; } r -= I_OUT;
        if (r < 2 * I_EG) { const int up = r / I_EG; r -= up * I_EG; const int e = r / 256, q = r % 256, kb = q / 16, nb = q % 16; const int n0 = 32 * nb;
            p0_transpose_item((up ? P.w_eu : P.w_eg) + (size_t)e * 1024 * 512, 1024, 512, Wgu_t, kb, nb, e * 1024 + (n0 >> 7) * 256 + up * 128 + (n0 & 127), scr, lane, 0, nullptr, nullptr); continue; } r -= 2 * I_EG;
        if (r < I_ED) { const int e = r / 256, q = r % 256, kb = q / 32, nb = q % 32; p0_transpose_item(P.w_ed + (size_t)e * 512 * 1024, 512, 1024, Wd_t, kb, nb, e * 1024 + 32 * nb, scr, lane, 0, nullptr, nullptr); continue; } r -= I_ED;
        if (r < I_PG) { const int kb = r / 32, nb = r % 32; p0_transpose_item(P.w_pg, 1024, 1024, Wpg_t, kb, nb, 32 * nb, scr, lane, 2, P.g_ple, nullptr); continue; } r -= I_PG;
        { const int kb = r / 32, nb = r % 32; p0_transpose_item(P.w_pp, 256, 1024, Wpp_t, kb, nb, 32 * nb, scr, lane, 0, nullptr, nullptr); }
    }
    bf16_t* XN = (bf16_t*)(P.ws + WS_XN); bf16_t* PB = (bf16_t*)(P.ws + WS_PB);
    f32x4 gm[4];
#pragma unroll
    for (int j = 0; j < 4; ++j) gm[j] = *((const f32x4*)P.g_mix + lane + 64 * j);
    for (int m = gw; m < NTOK; m += NGW) {
        const f32x4* xr = (const f32x4*)(P.x + (size_t)m * DM) + lane;
        f32x4 v[4]; float s = 0.f;
#pragma unroll
        for (int j = 0; j < 4; ++j) { v[j] = xr[64 * j]; s += (v[j].x * v[j].x + v[j].y * v[j].y) + (v[j].z * v[j].z + v[j].w * v[j].w); }
        const float rstd = 1.0f / sqrtf(wave_sum(s) * (1.0f / DM) + EPS);
        unsigned long long* o8 = (unsigned long long*)(XN + (size_t)m * DM) + lane;
#pragma unroll
        for (int j = 0; j < 4; ++j) { const f32x4 y = v[j] * rstd * gm[j]; o8[64 * j] = (unsigned long long)pk2(y.x, y.y) | ((unsigned long long)pk2(y.z, y.w) << 32); }
        const f32x4 pv = *((const f32x4*)(P.p + (size_t)m * PLE) + lane);
        *((unsigned long long*)(PB + (size_t)m * PLE) + lane) = (unsigned long long)pk2(pv.x, pv.y) | ((unsigned long long)pk2(pv.z, pv.w) << 32);
    }
}

__device__ __forceinline__ void p4_router(const Ptrs& P, LAS unsigned char* lds, unsigned* ctl, int vb, int nblk, int tid, int lane, int wave) {
    LAS float* WrT = (LAS float*)lds;
    LAS int* st_e = (LAS int*)(lds + 81920); LAS int* st_pos = st_e + 256; LAS int* st_tok = st_pos + 256; LAS float* st_w = (LAS float*)(st_tok + 256);
    LAS unsigned* lcnt = (LAS unsigned*)(st_w + 256); LAS unsigned* lbase = lcnt + 16;
    for (int i = tid; i < 20 * 1024; i += 512) { const int c = i >> 10, k = i & 1023; WrT[i] = (c < 4 ? P.w_rg[k * 4 + c] : P.w_re[k * 16 + (c - 4)]) * P.g_ffn[k]; }
    bf16_t* H2 = (bf16_t*)(P.ws + WS_XN); int* list = (int*)(P.ws + WS_LIST);
    f32x4 gf[4];
#pragma unroll
    for (int j = 0; j < 4; ++j) gf[j] = *((const f32x4*)P.g_ffn + lane + 64 * j);
    float bg[4], be[16];
#pragma unroll
    for (int i = 0; i < 4; ++i) bg[i] = P.b_rg[i];
#pragma unroll
    for (int i = 0; i < 16; ++i) be[i] = P.b_re[i];
    for (int blk = vb; blk < NTOK / 128; blk += nblk) {
        if (tid < 16) lcnt[tid] = 0u;
        __syncthreads();
        for (int rp = 0; rp < 8; ++rp) {
            const int m0 = blk * 128 + wave * 16 + rp * 2;
            f32x4 va[4], vb4[4]; float sa = 0.f, sb = 0.f;
#pragma unroll
            for (int j = 0; j < 4; ++j) { va[j] = *((const f32x4*)(P.out + (size_t)m0 * DM) + lane + 64 * j); vb4[j] = *((const f32x4*)(P.out + (size_t)(m0 + 1) * DM) + lane + 64 * j);
                sa += (va[j].x * va[j].x + va[j].y * va[j].y) + (va[j].z * va[j].z + va[j].w * va[j].w); sb += (vb4[j].x * vb4[j].x + vb4[j].y * vb4[j].y) + (vb4[j].z * vb4[j].z + vb4[j].w * vb4[j].w); }
            const float ra = 1.0f / sqrtf(wave_sum(sa) * (1.0f / DM) + EPS), rb = 1.0f / sqrtf(wave_sum(sb) * (1.0f / DM) + EPS);
            { unsigned long long* oa = (unsigned long long*)(H2 + (size_t)m0 * DM) + lane; unsigned long long* ob = (unsigned long long*)(H2 + (size_t)(m0 + 1) * DM) + lane;
#pragma unroll
              for (int j = 0; j < 4; ++j) { const f32x4 ya = va[j] * ra * gf[j], yb = vb4[j] * rb * gf[j];
                  oa[64 * j] = (unsigned long long)pk2(ya.x, ya.y) | ((unsigned long long)pk2(ya.z, ya.w) << 32); ob[64 * j] = (unsigned long long)pk2(yb.x, yb.y) | ((unsigned long long)pk2(yb.z, yb.w) << 32); } }
            float la[20], lb[20];
#pragma unroll
            for (int c = 0; c < 20; ++c) { float a = 0.f, b = 0.f;
#pragma unroll
                for (int j = 0; j < 4; ++j) { const f32x4 w = *((const LAS f32x4*)(WrT + c * 1024) + lane + 64 * j);
                    a += (va[j].x * w.x + va[j].y * w.y) + (va[j].z * w.z + va[j].w * w.w); b += (vb4[j].x * w.x + vb4[j].y * w.y) + (vb4[j].z * w.z + vb4[j].w * w.w); }
                la[c] = wave_sum(a) * ra; lb[c] = wave_sum(b) * rb; }
            float lg[20];
#pragma unroll
            for (int c = 0; c < 20; ++c) lg[c] = (lane == 1 ? lb[c] : la[c]) + (c < 4 ? bg[c] : be[c - 4]);
            int gi = 0; float gmax = lg[0];
#pragma unroll
            for (int i = 1; i < 4; ++i) if (lg[i] > gmax) { gmax = lg[i]; gi = i; }
            float gsum = 0.f;
#pragma unroll
            for (int i = 0; i < 4; ++i) gsum += __expf(lg[i] - gmax);
            const float gwt = 1.0f / gsum;
            float ig[4];
#pragma unroll
            for (int i = 0; i < 4; ++i) ig[i] = gi == 0 ? lg[4 + i] : gi == 1 ? lg[8 + i] : gi == 2 ? lg[12 + i] : lg[16 + i];
            int i0 = 0; float v0 = ig[0];
#pragma unroll
            for (int i = 1; i < 4; ++i) if (ig[i] > v0) { v0 = ig[i]; i0 = i; }
            int i1 = -1; float v1 = -INFINITY;
#pragma unroll
            for (int i = 0; i < 4; ++i) if (i != i0 && (i1 < 0 || ig[i] > v1)) { v1 = ig[i]; i1 = i; }
            const float w0 = 1.0f / (1.0f + __expf(v1 - v0)), w1 = 1.0f - w0;
            if (lane < 2) {
                const int m = m0 + lane, e0 = gi * 4 + i0, e1 = gi * 4 + i1, si = 2 * (wave * 16 + rp * 2 + lane);
                st_e[si] = e0; st_pos[si] = (int)atomicAdd((unsigned*)&lcnt[e0], 1u); st_tok[si] = 2 * m; st_w[si] = w0 * gwt;
                st_e[si + 1] = e1; st_pos[si + 1] = (int)atomicAdd((unsigned*)&lcnt[e1], 1u); st_tok[si + 1] = 2 * m + 1; st_w[si + 1] = w1 * gwt;
            }
        }
        __syncthreads();
        if (tid < 16) lbase[tid] = lcnt[tid] ? __hip_atomic_fetch_add(ctl + CW_CNT + 64 * tid, lcnt[tid], RLX_AGENT) : 0u;
        __syncthreads();
        if (tid < 256) { const int e = st_e[tid]; const size_t slot = (size_t)e * LIST_CAP + lbase[e] + st_pos[tid]; int2 ent; ent.x = st_tok[tid]; ent.y = __float_as_int(st_w[tid]); *(int2*)(list + 2 * slot) = ent; }
        __syncthreads();
    }
}

__device__ __forceinline__ void p7_rows(const Ptrs& P, int gw, int NGW, int lane) {
    bf16_t* H3 = (bf16_t*)(P.ws + WS_XN); const bf16_t* YB = (const bf16_t*)(P.ws + WS_YB);
    for (int m = gw; m < NTOK; m += NGW) {
        f32x4* xr = (f32x4*)(P.out + (size_t)m * DM) + lane;
        const u32x2* y0 = (const u32x2*)(YB + (size_t)(2 * m) * DM) + lane; const u32x2* y1 = (const u32x2*)(YB + (size_t)(2 * m + 1) * DM) + lane;
        f32x4 v[4]; float s = 0.f;
#pragma unroll
        for (int j = 0; j < 4; ++j) { v[j] = xr[64 * j]; const u32x2 a = y0[64 * j], b = y1[64 * j];
            v[j].x += bf_lo(a.x) + bf_lo(b.x); v[j].y += bf_hi(a.x) + bf_hi(b.x); v[j].z += bf_lo(a.y) + bf_lo(b.y); v[j].w += bf_hi(a.y) + bf_hi(b.y);
            s += (v[j].x * v[j].x + v[j].y * v[j].y) + (v[j].z * v[j].z + v[j].w * v[j].w); }
        const float rstd = 1.0f / sqrtf(wave_sum(s) * (1.0f / DM) + EPS);
        unsigned long long* o8 = (unsigned long long*)(H3 + (size_t)m * DM) + lane;
#pragma unroll
        for (int j = 0; j < 4; ++j) { xr[64 * j] = v[j]; const f32x4 y = v[j] * rstd; o8[64 * j] = (unsigned long long)pk2(y.x, y.y) | ((unsigned long long)pk2(y.z, y.w) << 32); }
    }
}
__device__ __forceinline__ void p10_rows(const Ptrs& P, int gw, int NGW, int lane) {
    f32x4 gf[4];
#pragma unroll
    for (int j = 0; j < 4; ++j) gf[j] = *((const f32x4*)P.g_final + lane + 64 * j);
    for (int m = gw; m < NTOK; m += NGW) {
        f32x4* xr = (f32x4*)(P.out + (size_t)m * DM) + lane;
        f32x4 v[4]; float s = 0.f;
#pragma unroll
        for (int j = 0; j < 4; ++j) { v[j] = xr[64 * j]; s += (v[j].x * v[j].x + v[j].y * v[j].y) + (v[j].z * v[j].z + v[j].w * v[j].w); }
        const float rstd = 1.0f / sqrtf(wave_sum(s) * (1.0f / DM) + EPS);
#pragma unroll
        for (int j = 0; j < 4; ++j) xr[64 * j] = v[j] * rstd * gf[j];
    }
}

constexpr int PER_PHASE = 11;
struct Args { const float* in[23]; float* out; unsigned char* ws; int ph_lo, ph_hi; };
__global__ void __launch_bounds__(NWAVES * 64, 2) hymba_fwd(Args args) {
    extern __shared__ __attribute__((aligned(16))) unsigned char lds_raw[];
    LAS unsigned char* lds = (LAS unsigned char*)lds_raw;
    volatile LAS unsigned* MISC = (volatile LAS unsigned*)(lds + MISC_OFF);
    const int wave = fresh_wave();
    const int G = gridDim.x; const int bx = blockIdx.x; const int vcu = (G % 8 == 0) ? (bx % 8) * (G / 8) + bx / 8 : bx;
    Ptrs P;
    P.x = args.in[0]; P.p = args.in[1]; P.g_mix = args.in[2]; P.w_in = args.in[3]; P.lq1 = args.in[4]; P.lk1 = args.in[5]; P.lq2 = args.in[6]; P.lk2 = args.in[7]; P.g_sb = args.in[8]; P.g_df = args.in[9];
    P.w_out = args.in[10]; P.g_ffn = args.in[11]; P.w_rg = args.in[12]; P.b_rg = args.in[13]; P.w_re = args.in[14]; P.b_re = args.in[15]; P.w_eg = args.in[16]; P.w_eu = args.in[17]; P.w_ed = args.in[18];
    P.g_ple = args.in[19]; P.w_pg = args.in[20]; P.w_pp = args.in[21]; P.g_final = args.in[22]; P.out = args.out; P.ws = args.ws;
    unsigned* ctl = (unsigned*)(args.ws + WS_CTL);
    for (int u = threadIdx.x; u < (LDS_BYTES - LDSCTL_OFF) / 4; u += NWAVES * 64) ((LAS unsigned*)(lds + LDSCTL_OFF))[u] = 0u;
    __syncthreads();
    const int lo = args.ph_lo, hi = args.ph_hi;
    XcdBarrier bar; bar.bar = ctl + CW_BAR; bar.x = 0; bar.st = nullptr;
    if (hi - lo > 1) bar = xcd_barrier_post(ctl + CW_BAR, MISC + 8);
#ifndef PHASE_MASK
#define PHASE_MASK 0x7ff
#endif
#define IN(k) (((PHASE_MASK >> (k)) & 1) && lo <= (k) && (k) < hi)
#define SEAM(k) do { if (IN(k) && IN((k) + 1)) xcd_barrier(bar); } while (0)
    const int gw = vcu * NWAVES + wave, NGW = G * NWAVES;
    bf16_t* XN = (bf16_t*)(args.ws + WS_XN); bf16_t* QKV = (bf16_t*)(args.ws + WS_QKV); bf16_t* OB = (bf16_t*)(args.ws + WS_OB);

    if (IN(0)) { p0_prologue(P, lds, gw, NGW, fresh_lane(), wave); }
    SEAM(0);
    if (IN(1)) {
        pg8::Gemm g{XN, (const bf16_t*)(args.ws + WS_WIN), 1024, nullptr, 0}; pg8::StaticOrder S; S.init(NTOK, NQKV, G, bx);
        pg8::EpiQKV E{QKV};
        pg8::gemm_phase<pg8::EpiQKV, pg8::StaticOrder, false>(lds, g, S, E);
    }
    SEAM(1);
    if (IN(2)) {
        char* shm = (char*)lds_raw;
        for (int i = 0; i < 4; ++i) { const int u = vcu * 4 + i; if (u < BATCH * 128) att::sb_unit(u >> 7, u & 127, i & 1, QKV, OB, shm); }
        __syncthreads();
        const int lane = fresh_lane();
        float d1 = P.lq1[lane] * P.lk1[lane], d2 = P.lq2[lane] * P.lk2[lane];
        const float lam = __expf(wave_sum(d1)) - __expf(wave_sum(d2)) + LAMBDA_INIT;
        if (vcu < 256) {
            const int bh = vcu >> 3, s = vcu & 7, b = bh >> 2, h = bh & 3;
            const float slope2 = exp2f(-2.0f * (float)(h + 1)) * LOG2E;
            for (int i = 0; i < 4; ++i) { const int qb = (i == 0) ? s : (i == 1) ? 31 - s : (i == 2) ? 15 - s : 16 + s; att::df_unit(b, h, qb, QKV, OB, shm, lam, slope2); }
        }
    }
    SEAM(2);
    if (IN(3)) {
        pg8::Gemm g{OB, (const bf16_t*)(args.ws + WS_WOUT), 1024, nullptr, 0}; pg8::StaticOrder S; S.init(NTOK, DM, G, bx);
        pg8::EpiResF32 E{P.x, P.out};
        pg8::gemm_phase<pg8::EpiResF32, pg8::StaticOrder, false>(lds, g, S, E);
    }
    SEAM(3);
    if (IN(4)) { const int lane = fresh_lane(); p4_router(P, lds, ctl, vcu, G, wave * 64 + lane, lane, wave); }
    SEAM(4);
    if (IN(5)) {
        pg8::Gemm g{XN, (const bf16_t*)(args.ws + WS_WGU), 1024, (const int*)(args.ws + WS_LIST), 0}; pg8::GroupedOrder S; S.init(ctl + CW_CNT, G, bx, 1, 1024);
        pg8::EpiSwiGLU E{(bf16_t*)(args.ws + WS_HID)};
        pg8::gemm_phase<pg8::EpiSwiGLU, pg8::GroupedOrder, true>(lds, g, S, E);
    }
    SEAM(5);
    if (IN(6)) {
        pg8::Gemm g{(const bf16_t*)(args.ws + WS_HID), (const bf16_t*)(args.ws + WS_WD), 512, nullptr, 0}; pg8::GroupedOrder S; S.init(ctl + CW_CNT, G, bx, 0, 1024);
        pg8::EpiDown E{(bf16_t*)(args.ws + WS_YB), (const int*)(args.ws + WS_LIST)};
        pg8::gemm_phase<pg8::EpiDown, pg8::GroupedOrder, false>(lds, g, S, E);
    }
    SEAM(6);
    if (IN(7)) { p7_rows(P, gw, NGW, fresh_lane()); }
    SEAM(7);
    if (IN(8)) {
        pg8::Gemm g{(const bf16_t*)(args.ws + WS_PB), (const bf16_t*)(args.ws + WS_WPP), 256, nullptr, 0}; pg8::StaticOrder S; S.init(NTOK, DM, G, bx);
        pg8::EpiBf16 E{(bf16_t*)(args.ws + WS_PP), DM};
        pg8::gemm_phase<pg8::EpiBf16, pg8::StaticOrder, false>(lds, g, S, E);
    }
    SEAM(8);
    if (IN(9)) {
        pg8::Gemm g{XN, (const bf16_t*)(args.ws + WS_WPG), 1024, nullptr, 0}; pg8::StaticOrder S; S.init(NTOK, DM, G, bx);
        pg8::EpiPle E{P.out, (const bf16_t*)(args.ws + WS_PP)};
        pg8::gemm_phase<pg8::EpiPle, pg8::StaticOrder, false>(lds, g, S, E);
    }
    SEAM(9);
    if (IN(10)) { p10_rows(P, gw, NGW, fresh_lane()); }
#undef IN
#undef SEAM
}

extern "C" void kernel_launch(void* const* d_in, const int* in_sizes, int n_in, void* d_out, int out_size, void* d_ws, size_t ws_size, hipStream_t stream) {
    static int grid = 0;
    if (grid == 0) {
        if (n_in != 23 || in_sizes[0] != NTOK * DM || out_size != NTOK * DM || ws_size < WS_END) { fprintf(stderr, "kernel_launch: unexpected shapes (n_in %d, in0 %d, out %d, ws %zu; need ws >= %zu); nothing launched\n", n_in, n_in > 0 ? in_sizes[0] : -1, out_size, ws_size, (size_t)WS_END); grid = -1; return; }
        int dev = 0, cus = 0, per_cu = 0;
        if (hipGetDevice(&dev) != hipSuccess || hipDeviceGetAttribute(&cus, hipDeviceAttributeMultiprocessorCount, dev) != hipSuccess) { fprintf(stderr, "kernel_launch: device query failed\n"); grid = -1; return; }
        if (hipFuncSetAttribute((const void*)hymba_fwd, hipFuncAttributeMaxDynamicSharedMemorySize, LDS_BYTES) != hipSuccess) { fprintf(stderr, "kernel_launch: hipFuncSetAttribute failed\n"); grid = -1; return; }
        if (hipOccupancyMaxActiveBlocksPerMultiprocessor(&per_cu, (const void*)hymba_fwd, NWAVES * 64, LDS_BYTES) != hipSuccess || per_cu < 1) { fprintf(stderr, "kernel_launch: occupancy query says %d blocks per CU; nothing launched\n", per_cu); (void)hipGetLastError(); grid = -1; return; }
        grid = cus;
        fprintf(stderr, "kernel_launch: %d CUs, occupancy %d/CU, grid %d\n", cus, per_cu, grid);
    }
    if (grid < 0) return;
    if (hipMemsetAsync((char*)d_ws + WS_CTL, 0, CTL_ZERO_BYTES, stream) != hipSuccess) { fprintf(stderr, "kernel_launch: memset failed\n"); return; }
    Args a{};
    for (int i = 0; i < 23; ++i) a.in[i] = (const float*)d_in[i];
    a.out = (float*)d_out; a.ws = (unsigned char*)d_ws;
#if MK_N_LAUNCHES == 1
    a.ph_lo = 0; a.ph_hi = PER_PHASE;
    void* kargs[] = {&a};
    hipError_t e = hipLaunchCooperativeKernel((const void*)hymba_fwd, dim3(grid), dim3(NWAVES * 64), kargs, LDS_BYTES, stream);
    if (e != hipSuccess) fprintf(stderr, "kernel_launch: cooperative launch failed: %s (grid %d)\n", hipGetErrorString(e), grid);
#else
    for (int li = 0; li < PER_PHASE; ++li) {
        a.ph_lo = li; a.ph_hi = li + 1;
        hipLaunchKernelGGL(hymba_fwd, dim3(grid), dim3(NWAVES * 64), LDS_BYTES, stream, a);
    }
#endif
}
```

```cpp
#include <hip/hip_runtime.h>
#include <hip/hip_bf16.h>
#include <cstdio>
#include <cstdint>

#ifndef MK_N_LAUNCHES
#define MK_N_LAUNCHES 1
#endif

#define LAS __attribute__((address_space(3)))
#define GAS __attribute__((address_space(1)))
typedef unsigned short bf16_t;
typedef short bf16x8 __attribute__((ext_vector_type(8)));
typedef short s16x4 __attribute__((ext_vector_type(4)));
typedef float f32x4 __attribute__((ext_vector_type(4)));
typedef float f32x2 __attribute__((ext_vector_type(2)));
typedef float f32x16 __attribute__((ext_vector_type(16)));
typedef unsigned u32x4 __attribute__((ext_vector_type(4)));
typedef unsigned u32x2 __attribute__((ext_vector_type(2)));

constexpr int BATCH = 8, SEQ = 4096, DM = 1024, NTOK = BATCH * SEQ;
constexpr int NQKV = 3072;
constexpr int COL_QSB = 0, COL_KSB = 512, COL_VSB = 1024, COL_QDF = 1536, COL_KDF = 2048, COL_VDF = 2560;
constexpr int NEXP = 16, DEXP = 512, PLE = 256;
constexpr float EPS = 1e-6f;
constexpr float LOG2E = 1.4426950408889634f;
constexpr float C2 = 0.125f * LOG2E;
constexpr float LAMBDA_INIT = 0.2f;
constexpr int LIST_CAP = NTOK;
constexpr int HID_ROWS = 2 * NTOK + NEXP * 256;

constexpr size_t MiB = 1u << 20;
constexpr size_t WS_CTL = 0, CTL_ZERO_BYTES = 1 * MiB;
constexpr size_t WS_WIN = 1 * MiB;
constexpr size_t WS_WOUT = 7 * MiB;
constexpr size_t WS_WGU = 9 * MiB;
constexpr size_t WS_WD = 41 * MiB;
constexpr size_t WS_WPG = 57 * MiB;
constexpr size_t WS_WPP = 59 * MiB;
constexpr size_t WS_LIST = 60 * MiB;
constexpr size_t WS_XN = 64 * MiB;
constexpr size_t WS_PB = 128 * MiB;
constexpr size_t WS_QKV = 144 * MiB;
constexpr size_t WS_HID = 144 * MiB;
constexpr size_t WS_PP = 212 * MiB;
constexpr size_t WS_OB = 336 * MiB;
constexpr size_t WS_YB = 336 * MiB;
constexpr size_t WS_END = 464 * MiB;
static_assert(WS_HID + (size_t)HID_ROWS * DEXP * 2 <= WS_PP && WS_PP + (size_t)NTOK * DM * 2 <= WS_QKV + (size_t)NTOK * NQKV * 2, "overlay map");
constexpr int CW_TMO = 0, CW_CODE = 1;
constexpr int CW_BAR = 4096;
constexpr int CW_CNT = 8192;

constexpr int RING_BYTES = 131072;
constexpr int LDSCTL_OFF = RING_BYTES, MISC_OFF = LDSCTL_OFF + 320;
constexpr int LDS_BYTES = 147456;
constexpr int NWAVES = 8;

#define RLX_AGENT __ATOMIC_RELAXED, __HIP_MEMORY_SCOPE_AGENT
#define LDS_WAIT() asm volatile("s_waitcnt lgkmcnt(0)" ::: "memory")
#define VM_WAIT() asm volatile("s_waitcnt vmcnt(0)" ::: "memory")
__device__ __forceinline__ unsigned cvt_pk_bf16(float lo, float hi) { unsigned r; asm volatile("v_cvt_pk_bf16_f32 %0, %1, %2" : "=v"(r) : "v"(lo), "v"(hi)); return r; }
__device__ __forceinline__ float bf_lo(unsigned u) { return __uint_as_float(u << 16); }
__device__ __forceinline__ float bf_hi(unsigned u) { return __uint_as_float(u & 0xffff0000u); }
__device__ __forceinline__ float wave_sum(float v) {
    v += __builtin_bit_cast(float, __builtin_amdgcn_update_dpp(0, __builtin_bit_cast(int, v), 0xB1, 0xF, 0xF, true));
    v += __builtin_bit_cast(float, __builtin_amdgcn_update_dpp(0, __builtin_bit_cast(int, v), 0x4E, 0xF, 0xF, true));
    v += __builtin_bit_cast(float, __builtin_amdgcn_update_dpp(0, __builtin_bit_cast(int, v), 0x141, 0xF, 0xF, true));
    v += __builtin_bit_cast(float, __builtin_amdgcn_update_dpp(0, __builtin_bit_cast(int, v), 0x140, 0xF, 0xF, true));
    { auto rr = __builtin_amdgcn_permlane16_swap(__float_as_uint(v), __float_as_uint(v), false, false); v = __uint_as_float(rr[0]) + __uint_as_float(rr[1]); }
    { auto rr = __builtin_amdgcn_permlane32_swap(__float_as_uint(v), __float_as_uint(v), false, false); v = __uint_as_float(rr[0]) + __uint_as_float(rr[1]); }
    return v;
}
__device__ __forceinline__ int fresh_lane() { int l; asm volatile("v_mbcnt_lo_u32_b32 %0, -1, 0\n\tv_mbcnt_hi_u32_b32 %0, -1, %0" : "=v"(l)); return l; }
__device__ __forceinline__ int fresh_wave() { return __builtin_amdgcn_readfirstlane((int)threadIdx.x >> 6); }
__device__ __forceinline__ float fast_rcp(float x) { return __builtin_amdgcn_rcpf(x); }
__device__ __forceinline__ float fast_exp2(float x) { return __builtin_amdgcn_exp2f(x); }
__device__ __forceinline__ float fast_log2(float x) { return __builtin_amdgcn_logf(x); }
__device__ __forceinline__ float sigmoidf_(float x) { return fast_rcp(1.0f + fast_exp2(-x * LOG2E)); }

namespace pg8 {
constexpr int BM = 256, BK = 64, HALF = 128, HTB = HALF * BK * 2, STAGE_BYTES = 8 * HTB, NXCD = 8, WGM = 8;
__host__ __device__ __forceinline__ int lds_byte(int r, int c) { const int st = (r >> 4) * 2 + (c >> 5), rr = r & 15, cc = c & 31, ob = rr * 64 + cc * 2; return st * 1024 + (ob ^ (((ob >> 9) & 1) << 5)); }
__host__ __device__ __forceinline__ void stage_rc(int b, int& R, int& C) { const int st = b / 1024, sb = b % 1024, swz = sb ^ (((sb >> 9) & 1) << 5); R = (st >> 1) * 16 + swz / 64; C = (st & 1) * 32 + (swz % 64) / 2; }
__host__ __device__ __forceinline__ int perm32(int rho) { const int n = rho >> 4, i = rho & 15; return 8 * (i >> 2) + 4 * n + (i & 3); }

struct Unit { int pm, pn, arow, brow, e, valid, lrow; };
struct Gemm { const bf16_t* A; const bf16_t* Bt; int K; const int* gidx; int gcap; };

struct StaticOrder {
    int nM, nN, nwg, G, c;
    __device__ void init(int M, int N, int G_, int c_) { nM = M / BM; nN = N / BM; nwg = nM * nN; G = G_; c = c_; }
    __device__ bool next(int i, Unit& u) const {
        const long L = (long)i * G + c; if (L >= nwg) return false;
        int wgid = (int)L; { const int q = nwg / NXCD, r = nwg % NXCD, xcd = wgid % NXCD, off = wgid / NXCD; wgid = (xcd < r ? xcd * (q + 1) : r * (q + 1) + (xcd - r) * q) + off; }
        const int nig = WGM * nN, gid = wgid / nig, fm = gid * WGM, gsz = (nM - fm) < WGM ? (nM - fm) : WGM;
        u.pm = fm + ((wgid % nig) % gsz); u.pn = (wgid % nig) / gsz; u.arow = u.pm * BM; u.brow = u.pn * BM; u.e = 0; u.valid = BM; u.lrow = 0; return true;
    }
};
struct GroupedOrder {
    const LAS int* cnt; int nwg, G, c; int listmode;
    int nbrow;
    __device__ void init(const unsigned* gcnt, LAS int* lcnt, int G_, int c_, int listmode_, int nbrow_) {
        { const int t_ = fresh_wave() * 64 + fresh_lane(); if (t_ < NEXP) lcnt[t_] = (int)__hip_atomic_load(gcnt + 64 * t_, RLX_AGENT); }
        __syncthreads();
        int tot = 0;
#pragma unroll
        for (int e = 0; e < NEXP; ++e) tot += (lcnt[e] + 255) >> 8;
        cnt = lcnt; nwg = __builtin_amdgcn_readfirstlane(tot * 4); G = G_; c = c_; listmode = listmode_; nbrow = nbrow_;
    }
    __device__ bool next(int i, Unit& u) const {
        const long L = (long)i * G + c; if (L >= nwg) return false;
        int wgid = (int)L; { const int q = nwg / NXCD, r = nwg % NXCD, xcd = wgid % NXCD, off = wgid / NXCD; wgid = (xcd < r ? xcd * (q + 1) : r * (q + 1) + (xcd - r) * q) + off; }
        int tile = wgid >> 2; const int pn = wgid & 3;
        int e = 0, hoff = 0, found = 0, mt = 0, hh = 0, ce = 0;
        for (int k = 0; k < NEXP; ++k) { const int ck = __builtin_amdgcn_readfirstlane(cnt[k]); const int tl = (ck + 255) >> 8; if (!found) { if (tile < tl) { found = 1; e = k; mt = tile; hh = hoff; ce = ck; } else { tile -= tl; hoff += tl; } } }
        u.e = e; u.pn = pn; u.pm = hh + mt;
        u.lrow = e * LIST_CAP + mt * BM;
        u.arow = listmode ? u.lrow : (hh + mt) * BM;
        u.brow = e * nbrow + pn * BM;
        const int rem = ce - mt * BM; u.valid = rem < BM ? rem : BM;
        return true;
    }
};

template <class Epi, class Sched, bool GATHER>
__device__ __forceinline__ void gemm_phase(LAS unsigned char* lds, const Gemm g, const Sched& S, const Epi& E) {
    const int wid = fresh_wave(), lane = fresh_lane(), tid = wid * 64 + lane, wr = wid >> 2, wc = wid & 3, fr = lane & 15, fq = lane >> 4;
    const int K = g.K, nt = K / BK;
    unsigned voffA[2], voffB[2]; int RA[2], CA;
#pragma unroll
    for (int i = 0; i < 2; ++i) { int R, C; stage_rc(tid * 16 + i * 8192, R, C); const int Rb = Epi::PERM ? ((R & ~31) + perm32(R & 31)) : R;
        voffA[i] = (unsigned)(R * K + C) * 2u; voffB[i] = (unsigned)(Rb * K + C) * 2u; RA[i] = R; CA = C; }
    const size_t kstep = (size_t)(BK * 2);
    const size_t hstep = (size_t)HALF * K * 2;
    const unsigned ldsw = (unsigned)wid * 1024u;
    const int aoff = lds_byte(wr * 64 + fr, fq * 8), boff = lds_byte(wc * 32 + fr, fq * 8);
#define PG8_SA(b, h) (((b) * 2 + (h)) * HTB)
#define PG8_SB(b, h) ((4 + (b) * 2 + (h)) * HTB)
#define PG8_STAGE(bufoff, gbase, voff) do { _Pragma("unroll") for (int _i = 0; _i < 2; ++_i) \
        __builtin_amdgcn_global_load_lds((const unsigned*)((const char*)(gbase) + (voff)[_i]), (LAS unsigned*)(lds + (bufoff) + ldsw + _i * 8192), 16, 0, 0); } while (0)
#define PG8_STAGE2(bufoff, gbase, v0, v1) do { \
        __builtin_amdgcn_global_load_lds((const unsigned*)((const char*)(gbase) + (v0)), (LAS unsigned*)(lds + (bufoff) + ldsw), 16, 0, 0); \
        __builtin_amdgcn_global_load_lds((const unsigned*)((const char*)(gbase) + (v1)), (LAS unsigned*)(lds + (bufoff) + ldsw + 8192), 16, 0, 0); } while (0)
#define PG8_LDA(dst, b, h) do { _Pragma("unroll") for (int m = 0; m < 4; ++m) _Pragma("unroll") for (int k = 0; k < 2; ++k) dst[m][k] = *(const LAS bf16x8*)(lds + PG8_SA(b, h) + aoff + m * 2048 + k * 1024); } while (0)
#define PG8_LDB(dst, b, h) do { _Pragma("unroll") for (int n = 0; n < 2; ++n) _Pragma("unroll") for (int k = 0; k < 2; ++k) dst[n][k] = *(const LAS bf16x8*)(lds + PG8_SB(b, h) + boff + n * 2048 + k * 1024); } while (0)
#define PG8_MMA(ai, bj, At, Bt) do { __builtin_amdgcn_s_setprio(1); _Pragma("unroll") for (int m = 0; m < 4; ++m) _Pragma("unroll") for (int n = 0; n < 2; ++n) _Pragma("unroll") for (int k = 0; k < 2; ++k) \
        acc[ai][bj][m][n] = __builtin_amdgcn_mfma_f32_16x16x32_bf16(Bt[n][k], At[m][k], acc[ai][bj][m][n], 0, 0, 0); __builtin_amdgcn_s_setprio(0); } while (0)
#define PG8_WAIT_V(n) asm volatile("s_waitcnt vmcnt(" #n ")" ::: "memory")
#define PG8_WAIT_L(n) asm volatile("s_waitcnt lgkmcnt(" #n ")" ::: "memory")
#define PG8_BAR __builtin_amdgcn_s_barrier()
#define PG8_SCHED __builtin_amdgcn_sched_barrier(0)
#define PG8_GOFF(dst, u) do { _Pragma("unroll") for (int _h = 0; _h < 2; ++_h) _Pragma("unroll") for (int _i = 0; _i < 2; ++_i) { const int _r = _h * HALF + RA[_i]; int _tok = 0; \
        if (_r < (u).valid) _tok = g.gidx[2 * ((u).arow + _r)] >> 1; dst[_h][_i] = (unsigned)(_tok * K + CA) * 2u; } } while (0)
    Unit cur, nxt; int ui = 0;
    if (!S.next(0, cur)) return;
    f32x4 acc[2][2][4][2];
#pragma unroll
    for (int a = 0; a < 2; ++a)
#pragma unroll
        for (int b = 0; b < 2; ++b)
#pragma unroll
            for (int m = 0; m < 4; ++m)
#pragma unroll
                for (int n = 0; n < 2; ++n) acc[a][b][m][n] = (f32x4){0.f, 0.f, 0.f, 0.f};
    bf16x8 At[4][2], B0[2][2], B1[2][2];
    unsigned gc[2][2], gn[2][2];
    const char* cA; const char* cB = (const char*)g.Bt + (size_t)cur.brow * K * 2;
    if constexpr (GATHER) { cA = (const char*)g.A; PG8_GOFF(gc, cur); } else { cA = (const char*)g.A + (size_t)cur.arow * K * 2; }
#define PG8_STA(bufoff, ab, ko, go, h) do { if constexpr (GATHER) { PG8_STAGE2(bufoff, (ab) + (ko), go[h][0], go[h][1]); } else { PG8_STAGE(bufoff, (ab) + (ko) + (h) * hstep, voffA); } } while (0)
    PG8_STAGE(PG8_SB(0, 0), cB, voffB); PG8_STAGE(PG8_SB(0, 1), cB + hstep, voffB); PG8_STA(PG8_SA(0, 0), cA, 0, gc, 0); PG8_STA(PG8_SA(0, 1), cA, 0, gc, 1);
    if (wr == 1) PG8_BAR;
    PG8_WAIT_V(2); PG8_BAR;
    PG8_STAGE(PG8_SB(1, 0), cB + kstep, voffB); PG8_STA(PG8_SA(1, 0), cA, kstep, gc, 0); PG8_STAGE(PG8_SB(1, 1), cB + hstep + kstep, voffB);
    PG8_WAIT_V(6); PG8_BAR;
    for (;;) {
        const bool has_next = S.next(ui + 1, nxt);
        const char* nA; const char* nB = has_next ? (const char*)g.Bt + (size_t)nxt.brow * K * 2 : cB;
        if constexpr (GATHER) { nA = cA; if (has_next) { PG8_GOFF(gn, nxt); } else {
#pragma unroll
            for (int h = 0; h < 2; ++h)
#pragma unroll
                for (int i = 0; i < 2; ++i) gn[h][i] = gc[h][i]; } }
        else { nA = has_next ? (const char*)g.A + (size_t)nxt.arow * K * 2 : cA; }
        for (int t = 0; t < nt; t += 2) {
            const bool last = (t == nt - 2);
            const size_t k1 = (size_t)(t + 1) * kstep;
            const char* a2 = last ? nA : cA; const size_t k2 = last ? 0 : (size_t)(t + 2) * kstep; const char* b2 = last ? nB : cB + (size_t)(t + 2) * kstep;
            const char* b3 = b2 + kstep; const size_t k3 = k2 + kstep;
            unsigned g2[2][2];
            if constexpr (GATHER) {
#pragma unroll
                for (int h = 0; h < 2; ++h)
#pragma unroll
                    for (int i = 0; i < 2; ++i) g2[h][i] = last ? gn[h][i] : gc[h][i]; }
            PG8_LDB(B0, 0, 0); PG8_LDB(B1, 0, 1); PG8_SCHED; PG8_LDA(At, 0, 0); PG8_STA(PG8_SA(1, 1), cA, k1, gc, 1);
            PG8_WAIT_V(8); PG8_WAIT_L(0); PG8_BAR; PG8_MMA(0, 0, At, B0); PG8_MMA(0, 1, At, B1); PG8_BAR; PG8_SCHED;
            PG8_LDA(At, 0, 1); PG8_STAGE(PG8_SB(0, 0), b2, voffB); PG8_STAGE(PG8_SB(0, 1), b2 + hstep, voffB); PG8_STA(PG8_SA(0, 0), a2, k2, g2, 0);
            PG8_WAIT_V(8); PG8_WAIT_L(0); PG8_BAR; PG8_MMA(1, 0, At, B0); PG8_MMA(1, 1, At, B1); PG8_BAR; PG8_SCHED;
            PG8_LDB(B0, 1, 0); PG8_LDB(B1, 1, 1); PG8_SCHED; PG8_LDA(At, 1, 0); PG8_STA(PG8_SA(0, 1), a2, k2, g2, 1);
            PG8_WAIT_V(8); PG8_WAIT_L(0); PG8_BAR; PG8_MMA(0, 0, At, B0); PG8_MMA(0, 1, At, B1); PG8_BAR; PG8_SCHED;
            PG8_LDA(At, 1, 1); PG8_STAGE(PG8_SB(1, 0), b3, voffB); PG8_STAGE(PG8_SB(1, 1), b3 + hstep, voffB); PG8_STA(PG8_SA(1, 0), a2, k3, g2, 0);
            PG8_WAIT_V(8); PG8_WAIT_L(0); PG8_BAR; PG8_MMA(1, 0, At, B0); PG8_MMA(1, 1, At, B1); PG8_BAR; PG8_SCHED;
        }
        if (wr == 0) PG8_BAR;
        E(acc, cur, wr, wc, fr, fq);
        if (!has_next) break;
#pragma unroll
        for (int a = 0; a < 2; ++a)
#pragma unroll
            for (int b = 0; b < 2; ++b)
#pragma unroll
                for (int m = 0; m < 4; ++m)
#pragma unroll
                    for (int n = 0; n < 2; ++n) acc[a][b][m][n] = (f32x4){0.f, 0.f, 0.f, 0.f};
        cur = nxt; cA = nA; cB = nB; ++ui;
        if constexpr (GATHER) {
#pragma unroll
            for (int h = 0; h < 2; ++h)
#pragma unroll
                for (int i = 0; i < 2; ++i) gc[h][i] = gn[h][i]; }
        if (wr == 1) PG8_BAR;
    }
    PG8_WAIT_V(0);
    PG8_BAR;
#undef PG8_SA
#undef PG8_SB
#undef PG8_STAGE
#undef PG8_STAGE2
#undef PG8_STA
#undef PG8_GOFF
#undef PG8_LDA
#undef PG8_LDB
#undef PG8_MMA
#undef PG8_WAIT_V
#undef PG8_WAIT_L
#undef PG8_BAR
#undef PG8_SCHED
}

struct EpiQKV {
    static constexpr bool PERM = true;
    bf16_t* O;
    __device__ __forceinline__ void operator()(const f32x4 (&acc)[2][2][4][2], const Unit& u, int wr, int wc, int fr, int fq) const {
        const int row0 = u.pm * BM + wr * 64 + fr, col0 = u.pn * BM + wc * 32 + 8 * fq;
        const float sc = (u.pn < 2 || (u.pn >= 6 && u.pn < 8)) ? C2 : 1.0f;
#pragma unroll
        for (int ai = 0; ai < 2; ++ai)
#pragma unroll
            for (int m = 0; m < 4; ++m) { bf16_t* rowp = O + (size_t)(row0 + ai * HALF + m * 16) * NQKV + col0;
#pragma unroll
                for (int bj = 0; bj < 2; ++bj) { const f32x4 v0 = acc[ai][bj][m][0] * sc, v1 = acc[ai][bj][m][1] * sc;
                    u32x4 w; w.x = cvt_pk_bf16(v0[0], v0[1]); w.y = cvt_pk_bf16(v0[2], v0[3]); w.z = cvt_pk_bf16(v1[0], v1[1]); w.w = cvt_pk_bf16(v1[2], v1[3]);
                    *(u32x4*)(rowp + bj * HALF) = w; } }
    }
};
struct EpiBf16 {
    static constexpr bool PERM = true;
    bf16_t* O; int ldc;
    __device__ __forceinline__ void operator()(const f32x4 (&acc)[2][2][4][2], const Unit& u, int wr, int wc, int fr, int fq) const {
        const int row0 = u.pm * BM + wr * 64 + fr, col0 = u.pn * BM + wc * 32 + 8 * fq;
#pragma unroll
        for (int ai = 0; ai < 2; ++ai)
#pragma unroll
            for (int m = 0; m < 4; ++m) { bf16_t* rowp = O + (size_t)(row0 + ai * HALF + m * 16) * ldc + col0;
#pragma unroll
                for (int bj = 0; bj < 2; ++bj) { const f32x4 v0 = acc[ai][bj][m][0], v1 = acc[ai][bj][m][1];
                    u32x4 w; w.x = cvt_pk_bf16(v0[0], v0[1]); w.y = cvt_pk_bf16(v0[2], v0[3]); w.z = cvt_pk_bf16(v1[0], v1[1]); w.w = cvt_pk_bf16(v1[2], v1[3]);
                    *(u32x4*)(rowp + bj * HALF) = w; } }
    }
};
struct EpiResF32 {
    static constexpr bool PERM = false;
    const float* base; float* out;
    __device__ __forceinline__ void operator()(const f32x4 (&acc)[2][2][4][2], const Unit& u, int wr, int wc, int fr, int fq) const {
        const int row0 = u.pm * BM + wr * 64 + fr, col0 = u.pn * BM + wc * 32 + 4 * fq;
#pragma unroll
        for (int ai = 0; ai < 2; ++ai)
#pragma unroll
            for (int m = 0; m < 4; ++m) { const size_t off = (size_t)(row0 + ai * HALF + m * 16) * DM + col0;
#pragma unroll
                for (int bj = 0; bj < 2; ++bj)
#pragma unroll
                    for (int n = 0; n < 2; ++n) { const f32x4 b = *(const f32x4*)(base + off + bj * HALF + n * 16); *(f32x4*)(out + off + bj * HALF + n * 16) = b + acc[ai][bj][m][n]; } }
    }
};
struct EpiSwiGLU {
    static constexpr bool PERM = true;
    bf16_t* O;
    __device__ __forceinline__ void operator()(const f32x4 (&acc)[2][2][4][2], const Unit& u, int wr, int wc, int fr, int fq) const {
        const int row0 = u.pm * BM + wr * 64 + fr, col0 = u.pn * HALF + wc * 32 + 8 * fq;
#pragma unroll
        for (int ai = 0; ai < 2; ++ai)
#pragma unroll
            for (int m = 0; m < 4; ++m) { bf16_t* rowp = O + (size_t)(row0 + ai * HALF + m * 16) * DEXP + col0;
                float h[8];
#pragma unroll
                for (int n = 0; n < 2; ++n)
#pragma unroll
                    for (int j = 0; j < 4; ++j) { const float gt = acc[ai][0][m][n][j], up = acc[ai][1][m][n][j]; h[4 * n + j] = gt * sigmoidf_(gt) * up; }
                u32x4 w; w.x = cvt_pk_bf16(h[0], h[1]); w.y = cvt_pk_bf16(h[2], h[3]); w.z = cvt_pk_bf16(h[4], h[5]); w.w = cvt_pk_bf16(h[6], h[7]);
                *(u32x4*)rowp = w; }
    }
};
struct EpiDown {
    static constexpr bool PERM = true;
    bf16_t* O; const int* list;
    __device__ __forceinline__ void operator()(const f32x4 (&acc)[2][2][4][2], const Unit& u, int wr, int wc, int fr, int fq) const {
        const int r0 = wr * 64 + fr, col0 = u.pn * BM + wc * 32 + 8 * fq;
#pragma unroll
        for (int ai = 0; ai < 2; ++ai)
#pragma unroll
            for (int m = 0; m < 4; ++m) { const int r = r0 + ai * HALF + m * 16;
                if (r < u.valid) { const int2 ent = *(const int2*)(list + 2 * (size_t)(u.lrow + r)); const float w = __int_as_float(ent.y);
                    bf16_t* rowp = O + (size_t)ent.x * DM + col0;
#pragma unroll
                    for (int bj = 0; bj < 2; ++bj) { const f32x4 v0 = acc[ai][bj][m][0] * w, v1 = acc[ai][bj][m][1] * w;
                        u32x4 q; q.x = cvt_pk_bf16(v0[0], v0[1]); q.y = cvt_pk_bf16(v0[2], v0[3]); q.z = cvt_pk_bf16(v1[0], v1[1]); q.w = cvt_pk_bf16(v1[2], v1[3]);
                        *(u32x4*)(rowp + bj * HALF) = q; } } }
    }
};
struct EpiPle {
    static constexpr bool PERM = false;
    float* X; const bf16_t* PP;
    __device__ __forceinline__ void operator()(const f32x4 (&acc)[2][2][4][2], const Unit& u, int wr, int wc, int fr, int fq) const {
        const int row0 = u.pm * BM + wr * 64 + fr, col0 = u.pn * BM + wc * 32 + 4 * fq;
#pragma unroll
        for (int ai = 0; ai < 2; ++ai)
#pragma unroll
            for (int m = 0; m < 4; ++m) { const size_t off = (size_t)(row0 + ai * HALF + m * 16) * DM + col0;
#pragma unroll
                for (int bj = 0; bj < 2; ++bj)
#pragma unroll
                    for (int n = 0; n < 2; ++n) { const size_t o2 = off + bj * HALF + n * 16; const f32x4 b = *(const f32x4*)(X + o2); const u32x2 pw = *(const u32x2*)(PP + o2); const f32x4 a = acc[ai][bj][m][n];
                        f32x4 r; r[0] = b[0] + sigmoidf_(a[0]) * bf_lo(pw.x); r[1] = b[1] + sigmoidf_(a[1]) * bf_hi(pw.x); r[2] = b[2] + sigmoidf_(a[2]) * bf_lo(pw.y); r[3] = b[3] + sigmoidf_(a[3]) * bf_hi(pw.y);
                        *(f32x4*)(X + o2) = r; } }
    }
};
}

namespace att {
typedef __attribute__((address_space(3))) const char* lds_cptr;
typedef short v4i16_t __attribute__((ext_vector_type(4)));
__device__ __forceinline__ int crow(int r, int hi) { return (r & 3) + 8 * (r >> 2) + 4 * hi; }
__device__ __forceinline__ void glds16(const void* gsrc, unsigned lds_dst) { unsigned keep;
    asm volatile("s_mov_b32 %0, m0\n\ts_mov_b32 m0, %2\n\ts_nop 0\n\tglobal_load_lds_dwordx4 %1, off\n\ts_mov_b32 m0, %0" : "=&s"(keep) : "v"(gsrc), "s"(lds_dst) : "memory"); }
__device__ __forceinline__ s16x4 vtr(lds_cptr p) { return __builtin_bit_cast(s16x4, __builtin_amdgcn_ds_read_tr16_b64_v4i16((__attribute__((address_space(3))) v4i16_t*)p)); }
__device__ __forceinline__ float swap_sum(float v) { auto rr = __builtin_amdgcn_permlane32_swap(__float_as_uint(v), __float_as_uint(v), false, false); return __uint_as_float(rr[0]) + __uint_as_float(rr[1]); }
__device__ __forceinline__ float swap_max(float v) { auto rr = __builtin_amdgcn_permlane32_swap(__float_as_uint(v), __float_as_uint(v), false, false); return fmaxf(__uint_as_float(rr[0]), __uint_as_float(rr[1])); }
#define ATT_MFMA(A, B, C) __builtin_amdgcn_mfma_f32_32x32x16_bf16((A), (B), (C), 0, 0, 0)
#define ATT_VFRAG(p) ({ const s16x4 _lo = vtr(p); const s16x4 _hi = vtr((p) + 512); (bf16x8){_lo[0], _lo[1], _lo[2], _lo[3], _hi[0], _hi[1], _hi[2], _hi[3]}; })

__device__ __forceinline__ void sb_unit(int b, int qi, int parity, const bf16_t* __restrict__ QKV, bf16_t* __restrict__ OB, char* shm) {
    const int lane = fresh_lane(), r32 = lane & 31, hi = lane >> 5; const int wid = fresh_wave();
    const long rowbase = (long)b * SEQ; const int t0 = qi * 32, h = wid;
    const bf16_t* Qp = QKV + (rowbase + t0 + r32) * NQKV + COL_QSB + h * 64 + hi * 8;
    bf16x8 qr[4];
#pragma unroll
    for (int d0 = 0; d0 < 4; ++d0) qr[d0] = *(const bf16x8*)(Qp + 16 * d0);
    const bf16_t* Kh = QKV + rowbase * NQKV + COL_KSB + h * 64;
    const bf16_t* Vh = QKV + rowbase * NQKV + COL_VSB + h * 64;
    char* vimg = shm + 8192 * wid;
    const lds_cptr vp0 = (lds_cptr)vimg + ((lane >> 4) & 1) * 32 + (lane & 3) * 8 + (4 * hi + ((lane & 15) >> 2)) * 64;
    f32x16 o0 = {}, o1 = {};
    float R = 0.f;
    const int jd = qi >> 1, tq = t0 + r32;
    for (int j = jd; j >= 0; --j) {
        const int kb = 64 * j;
        u32x4 vv[8];
#pragma unroll
        for (int it = 0; it < 8; ++it) vv[it] = *(const u32x4*)(Vh + (long)(kb + 8 * it + (lane >> 3)) * NQKV + (lane & 7) * 8);
        f32x16 p0 = {}, p1 = {};
#pragma unroll
        for (int d0 = 0; d0 < 4; ++d0) {
            const bf16x8 k0 = *(const bf16x8*)(Kh + (long)(kb + r32) * NQKV + 16 * d0 + 8 * hi);
            const bf16x8 k1 = *(const bf16x8*)(Kh + (long)(kb + 32 + r32) * NQKV + 16 * d0 + 8 * hi);
            p0 = ATT_MFMA(k0, qr[d0], p0); p1 = ATT_MFMA(k1, qr[d0], p1);
        }
#pragma unroll
        for (int it = 0; it < 8; ++it) *(u32x4*)(vimg + ((lane & 7) >> 2) * 4096 + (8 * it + (lane >> 3)) * 64 + (lane & 3) * 16) = vv[it];
        float lk[32], lb[32];
#pragma unroll
        for (int r = 0; r < 32; ++r) { const float z = (r < 16) ? p0[r & 15] : p1[r & 15];
            const float sp = fmaxf(z, 0.f) + fast_log2(1.0f + fast_exp2(-fabsf(z)));
            lk[r] = -sp; lb[r] = z - sp; }
        if (j == jd) {
#pragma unroll
            for (int r = 0; r < 32; ++r) { const int key = kb + crow(r & 15, hi) + (r >> 4) * 32; if (key >= tq) { lk[r] = 0.f; lb[r] = -INFINITY; } }
        }
        float lo[8], hv[8];
#pragma unroll
        for (int i = 0; i < 8; ++i) { const float gs = (lk[4 * i] + lk[4 * i + 1]) + (lk[4 * i + 2] + lk[4 * i + 3]);
            auto rr = __builtin_amdgcn_permlane32_swap(__float_as_uint(gs), __float_as_uint(gs), false, false); lo[i] = __uint_as_float(rr[0]); hv[i] = __uint_as_float(rr[1]); }
        float T = 0.f;
        float w[32];
#pragma unroll
        for (int i = 7; i >= 0; --i) {
            const float E = R + T + (hi == 0 ? hv[i] : 0.f);
            const float c3 = E, c2 = c3 + lk[4 * i + 3], c1 = c2 + lk[4 * i + 2], c0 = c1 + lk[4 * i + 1];
            w[4 * i + 3] = fast_exp2(lb[4 * i + 3] + c3); w[4 * i + 2] = fast_exp2(lb[4 * i + 2] + c2); w[4 * i + 1] = fast_exp2(lb[4 * i + 1] + c1); w[4 * i] = fast_exp2(lb[4 * i] + c0);
            T += lo[i] + hv[i];
        }
        R += T;
        u32x4 pw[4];
#pragma unroll
        for (int s = 0; s < 4; ++s) { pw[s].x = cvt_pk_bf16(w[8 * s], w[8 * s + 1]); pw[s].y = cvt_pk_bf16(w[8 * s + 2], w[8 * s + 3]); pw[s].z = cvt_pk_bf16(w[8 * s + 4], w[8 * s + 5]); pw[s].w = cvt_pk_bf16(w[8 * s + 6], w[8 * s + 7]); }
#pragma unroll
        for (int s = 0; s < 4; ++s) {
            const bf16x8 v0 = ATT_VFRAG(vp0 + s * 1024), v1 = ATT_VFRAG(vp0 + 4096 + s * 1024);
            o0 = ATT_MFMA(v0, __builtin_bit_cast(bf16x8, pw[s]), o0); o1 = ATT_MFMA(v1, __builtin_bit_cast(bf16x8, pw[s]), o1);
        }
        if (__all(R < -152.0f)) break;
    }
    float ss = 0.f;
#pragma unroll
    for (int r = 0; r < 16; ++r) ss += o0[r] * o0[r] + o1[r] * o1[r];
    ss = swap_sum(ss);
    float* red = (float*)(shm + 65536) + parity * 256;
    if (hi == 0) red[wid * 32 + r32] = ss;
    __syncthreads();
    float tot = 0.f;
#pragma unroll
    for (int w8 = 0; w8 < 8; ++w8) tot += red[w8 * 32 + r32];
    const float rstd = 1.0f / sqrtf(tot * (1.0f / 512.0f) + EPS);
    bf16_t* Op = OB + (rowbase + t0 + r32) * DM + h * 64 + 4 * hi;
#pragma unroll
    for (int i = 0; i < 4; ++i) {
        u32x2 a; a.x = cvt_pk_bf16(o0[4 * i] * rstd, o0[4 * i + 1] * rstd); a.y = cvt_pk_bf16(o0[4 * i + 2] * rstd, o0[4 * i + 3] * rstd); *(u32x2*)(Op + 8 * i) = a;
        u32x2 c; c.x = cvt_pk_bf16(o1[4 * i] * rstd, o1[4 * i + 1] * rstd); c.y = cvt_pk_bf16(o1[4 * i + 2] * rstd, o1[4 * i + 3] * rstd); *(u32x2*)(Op + 32 + 8 * i) = c;
    }
}

constexpr int DF_SLOT = 32768, DF_THR = 8;
__device__ __forceinline__ void df_unit(int b, int h, int qb, const bf16_t* __restrict__ QKV, bf16_t* __restrict__ OB, char* shm, float lam, float slope2) {
    const int lane = fresh_lane(), r32 = lane & 31, hi = lane >> 5; const int wid = fresh_wave();
    const int c = wid & 1, qs = wid >> 1;
    const long rowbase = (long)b * SEQ; const int t0 = qb * 128, tq0 = t0 + 32 * qs, NT = 2 * qb + 2, jdw = 2 * qb + (qs >> 1);
    const bf16_t* Kg = QKV + rowbase * NQKV + COL_KDF + h * 128;
    const bf16_t* Vg = QKV + rowbase * NQKV + COL_VDF + h * 128;
    const unsigned lds0 = (unsigned)(uintptr_t)shm;
    const bf16_t* ksrc0 = Kg + (long)lane * NQKV + wid * 8;
    const bf16_t* ksrc1 = ksrc0 + 64;
    const bf16_t* vsrc0 = Vg + (long)(16 * (wid & 3) + (lane >> 2)) * NQKV + (wid >> 2) * 32 + (lane & 3) * 8;
    const bf16_t* vsrc1 = vsrc0 + 64;
#define DF_DMA(j, slot) do { const long _ro = (long)(j) * 64 * NQKV; const unsigned _d = (unsigned)__builtin_amdgcn_readfirstlane(lds0 + (slot) * DF_SLOT + wid * 1024); \
        glds16(ksrc0 + _ro, _d); glds16(ksrc1 + _ro, _d + 8192); glds16(vsrc0 + _ro, _d + 16384); glds16(vsrc1 + _ro, _d + 16384 + 8192); } while (0)
    DF_DMA(NT - 1, 0); DF_DMA(NT - 2, 1);
    const bf16_t* Qp = QKV + (rowbase + tq0 + r32) * NQKV + COL_QDF + h * 128 + c * 64 + hi * 8;
    bf16x8 qr[4];
#pragma unroll
    for (int d0 = 0; d0 < 4; ++d0) qr[d0] = *(const bf16x8*)(Qp + 16 * d0);
    __builtin_amdgcn_s_waitcnt(0);
#pragma unroll
    for (int d0 = 0; d0 < 4; ++d0) asm volatile("" : "+v"(qr[d0]));
    f32x16 o[4]; o[0] = f32x16{}; o[1] = f32x16{}; o[2] = f32x16{}; o[3] = f32x16{};
    float mhat = 0.f, l = 0.f; bool first = true;
    const lds_cptr shm3 = (lds_cptr)shm;
    const int koff = (8 * c + hi) * 1024 + r32 * 16;
    const int voff = 16384 + ((lane >> 4) & 1) * 32 + (lane & 3) * 8 + (4 * hi + ((lane & 15) >> 2)) * 64;
    const int tq = tq0 + r32;
    int slot = 0;
    for (int st = 0; st < NT; ++st) {
        const int j = NT - 1 - st;
        if (st + 1 < NT) asm volatile("s_waitcnt vmcnt(4) lgkmcnt(0)\n\ts_barrier" ::: "memory"); else asm volatile("s_waitcnt vmcnt(0) lgkmcnt(0)\n\ts_barrier" ::: "memory");
        if (st + 2 < NT) { const int s2 = (slot + 2 >= 3) ? slot - 1 : slot + 2; DF_DMA(j - 2, s2); }
        if (j <= jdw) {
            const lds_cptr kp = shm3 + slot * DF_SLOT + koff; const lds_cptr vp = shm3 + slot * DF_SLOT + voff;
            const int kb = 64 * j;
            const float basev = slope2 * (float)(kb - tq0 + 4 * hi) - mhat;
            f32x16 p0, p1;
#pragma unroll
            for (int r = 0; r < 16; ++r) { p0[r] = basev + slope2 * (float)((r & 3) + 8 * (r >> 2)); p1[r] = p0[r] + slope2 * 32.0f; }
#pragma unroll
            for (int d0 = 0; d0 < 4; ++d0) {
                const bf16x8 k0 = *(const __attribute__((address_space(3))) bf16x8*)(kp + d0 * 2048);
                const bf16x8 k1 = *(const __attribute__((address_space(3))) bf16x8*)(kp + d0 * 2048 + 512);
                p0 = ATT_MFMA(k0, qr[d0], p0); p1 = ATT_MFMA(k1, qr[d0], p1);
            }
            if (j == jdw) {
#pragma unroll
                for (int r = 0; r < 16; ++r) { const int key = kb + crow(r, hi); if (key > tq) p0[r] = -INFINITY; if (key + 32 > tq) p1[r] = -INFINITY; }
            }
            float rm = fmaxf(p0[0], p1[0]);
#pragma unroll
            for (int r = 1; r < 16; ++r) rm = fmaxf(rm, fmaxf(p0[r], p1[r]));
            rm = swap_max(rm);
            if (first || __any(rm > (float)DF_THR)) {
                const float dl = first ? rm : fmaxf(rm, 0.f); mhat += dl;
#pragma unroll
                for (int r = 0; r < 16; ++r) { p0[r] -= dl; p1[r] -= dl; }
                const float f = fast_exp2(-dl); l *= f;
#pragma unroll
                for (int d = 0; d < 4; ++d)
#pragma unroll
                    for (int r = 0; r < 16; ++r) o[d][r] *= f;
                first = false;
            }
            float sacc = 0.f;
#pragma unroll
            for (int r = 0; r < 16; ++r) { p0[r] = fast_exp2(p0[r]); p1[r] = fast_exp2(p1[r]); sacc += p0[r] + p1[r]; }
            l += sacc;
            u32x4 pw[4];
#pragma unroll
            for (int s = 0; s < 2; ++s) { pw[s].x = cvt_pk_bf16(p0[8 * s], p0[8 * s + 1]); pw[s].y = cvt_pk_bf16(p0[8 * s + 2], p0[8 * s + 3]); pw[s].z = cvt_pk_bf16(p0[8 * s + 4], p0[8 * s + 5]); pw[s].w = cvt_pk_bf16(p0[8 * s + 6], p0[8 * s + 7]);
                pw[2 + s].x = cvt_pk_bf16(p1[8 * s], p1[8 * s + 1]); pw[2 + s].y = cvt_pk_bf16(p1[8 * s + 2], p1[8 * s + 3]); pw[2 + s].z = cvt_pk_bf16(p1[8 * s + 4], p1[8 * s + 5]); pw[2 + s].w = cvt_pk_bf16(p1[8 * s + 6], p1[8 * s + 7]); }
#pragma unroll
            for (int s = 0; s < 4; ++s)
#pragma unroll
                for (int d = 0; d < 4; ++d) { const bf16x8 vf = ATT_VFRAG(vp + d * 4096 + s * 1024); o[d] = ATT_MFMA(vf, __builtin_bit_cast(bf16x8, pw[s]), o[d]); }
        }
        slot = (slot == 2) ? 0 : slot + 1;
    }
#undef DF_DMA
    asm volatile("s_waitcnt vmcnt(0) lgkmcnt(0)\n\ts_barrier" ::: "memory");
    l = swap_sum(l);
    const float inv = 1.0f / l;
    float* xch = (float*)shm + qs * 4096;
    if (c == 1) {
        const float sc = inv * lam;
#pragma unroll
        for (int d = 0; d < 4; ++d)
#pragma unroll
            for (int r = 0; r < 16; ++r) xch[(d * 16 + r) * 64 + lane] = o[d][r] * sc;
    }
    __syncthreads();
    if (c == 0) {
        float ss = 0.f;
#pragma unroll
        for (int d = 0; d < 4; ++d)
#pragma unroll
            for (int r = 0; r < 16; ++r) { const float v = o[d][r] * inv - xch[(d * 16 + r) * 64 + lane]; o[d][r] = v; ss += v * v; }
        ss = swap_sum(ss);
        const float rstd = 1.0f / sqrtf(ss * (1.0f / 128.0f) + EPS);
        bf16_t* Op = OB + (rowbase + tq0 + r32) * DM + 512 + h * 128 + 4 * hi;
#pragma unroll
        for (int d = 0; d < 4; ++d)
#pragma unroll
            for (int i = 0; i < 4; ++i) { u32x2 a; a.x = cvt_pk_bf16(o[d][4 * i] * rstd, o[d][4 * i + 1] * rstd); a.y = cvt_pk_bf16(o[d][4 * i + 2] * rstd, o[d][4 * i + 3] * rstd); *(u32x2*)(Op + d * 32 + 8 * i) = a; }
    }
    __syncthreads();
}
}

#define XB_TMO      128
#define XB_XCNT(j)  (256  + 64 * (j))
#define XB_XSUB(j)  (1280 + 64 * (j))
#define XB_XGEN(j)  (2304 + 64 * (j))
#define XB_TOP      3328
#define XB_TOPGEN   3392
#define XCD_BAR_WORDS 3456
#define XB_SPIN_CAP (1u << 18)
__device__ __forceinline__ unsigned xb_ld(unsigned* p)              { return __hip_atomic_load(p, __ATOMIC_RELAXED, __HIP_MEMORY_SCOPE_AGENT); }
__device__ __forceinline__ unsigned xb_add(unsigned* p, unsigned v) { return __hip_atomic_fetch_add(p, v, __ATOMIC_RELAXED, __HIP_MEMORY_SCOPE_AGENT); }
__device__ __forceinline__ unsigned xb_xcc_id() { return (unsigned)__builtin_amdgcn_s_getreg((3 << 11) | 20) & 0xFu; }
#define XB_SPIN(cond, bar) do { unsigned _sp = 0; while (cond) { __builtin_amdgcn_s_sleep(1); \
    if ((++_sp & 255u) == 0u) { if (xb_ld(&(bar)[XB_TMO])) break; if (_sp > XB_SPIN_CAP) { atomicAdd(&(bar)[XB_TMO], 1u); break; } } } } while (0)
struct XcdBarrier { unsigned* bar; unsigned x; volatile LAS unsigned* st; };
__device__ __forceinline__ XcdBarrier xcd_barrier_post(unsigned* bar, volatile LAS unsigned* st) {
    XcdBarrier b; b.bar = bar; b.x = xb_xcc_id(); b.st = st;
    if (threadIdx.x == 0) (void)xb_add(&bar[XB_XCNT(b.x)], 1u);
    return b;
}
__device__ __forceinline__ void xcd_barrier_complete(unsigned* bar, unsigned x, unsigned& nloc, unsigned& nx) {
    const unsigned G = gridDim.x * gridDim.y * gridDim.z;
    unsigned sum, cnt, mine, sp = 0u;
    for (;;) {
        sum = 0u; cnt = 0u; mine = 0u;
#pragma unroll
        for (unsigned j = 0; j < 16; ++j) { const unsigned c = xb_ld(&bar[XB_XCNT(j)]); sum += c; cnt += (c > 0u) ? 1u : 0u; mine = (j == x) ? c : mine; }
        if (sum == G) break;
        __builtin_amdgcn_s_sleep(1);
        if ((++sp & 255u) == 0u) { if (xb_ld(&bar[XB_TMO])) break; if (sp > XB_SPIN_CAP) { atomicAdd(&bar[XB_TMO], 1u); break; } }
    }
    nloc = mine > 0u ? mine : 1u; nx = cnt > 0u ? cnt : 1u;
}
__device__ __forceinline__ void xcd_barrier(const XcdBarrier& b) {
    asm volatile("s_waitcnt vmcnt(0)" ::: "memory");
    __syncthreads();
    if (threadIdx.x == 0) {
        unsigned* bar = b.bar;
        __builtin_amdgcn_s_waitcnt(0);
        unsigned nloc = b.st[0], nx = b.st[1];
        if (nloc == 0u) { xcd_barrier_complete(bar, b.x, nloc, nx); b.st[0] = nloc; b.st[1] = nx; }
        const unsigned old = xb_add(&bar[XB_XSUB(b.x)], 1u);
        const unsigned gen = old / nloc;
        if (old + 1u == (gen + 1u) * nloc) {
            __builtin_amdgcn_fence(__ATOMIC_RELEASE, "agent");
            asm volatile("s_waitcnt vmcnt(0)" ::: "memory");
            const unsigned og = xb_add(&bar[XB_TOP], 1u);
            const unsigned tg = og / nx;
            if (og + 1u == (tg + 1u) * nx) xb_add(&bar[XB_TOPGEN], 1u);
            else XB_SPIN(xb_ld(&bar[XB_TOPGEN]) == tg, bar);
            __builtin_amdgcn_fence(__ATOMIC_ACQUIRE, "agent");
            xb_add(&bar[XB_XGEN(b.x)], 1u);
            asm volatile("s_waitcnt vmcnt(0)" ::: "memory");
        } else {
            XB_SPIN(xb_ld(&bar[XB_XGEN(b.x)]) == gen, bar);
            __builtin_amdgcn_fence(__ATOMIC_ACQUIRE, "agent");
            asm volatile("s_waitcnt vmcnt(0)" ::: "memory");
        }
    }
    __syncthreads();
}

__device__ __forceinline__ unsigned pk2(float lo, float hi) { return cvt_pk_bf16(lo, hi); }
__device__ __forceinline__ void p0_transpose_item(const float* __restrict__ W, int K, int N, bf16_t* __restrict__ WT, int kb, int nb, int wtrow, LAS float* scr, int lane, int mode, const float* __restrict__ g0, const float* __restrict__ g1) {
    const int k0 = 64 * kb, n0 = 32 * nb;
#pragma unroll 8
    for (int i = 0; i < 32; ++i) { const int kk = 2 * i + (lane >> 5); float v = W[(size_t)(k0 + kk) * N + n0 + (lane & 31)];
        if (mode == 1) { const int k = k0 + kk; v *= (k < 512) ? g0[k] : g1[(k - 512) & 127] * (1.0f - LAMBDA_INIT); }
        else if (mode == 2) { v *= g0[k0 + kk]; }
        scr[kk * 33 + (lane & 31)] = v; }
    LDS_WAIT(); asm volatile("" ::: "memory");
    const int c = lane & 7;
#pragma unroll
    for (int j = 0; j < 4; ++j) { const int n = (lane >> 3) + 8 * j; const LAS float* s = scr + (8 * c) * 33 + n;
        u32x4 o; o.x = pk2(s[0 * 33], s[1 * 33]); o.y = pk2(s[2 * 33], s[3 * 33]); o.z = pk2(s[4 * 33], s[5 * 33]); o.w = pk2(s[6 * 33], s[7 * 33]);
        *(u32x4*)(WT + (size_t)(wtrow + n) * K + k0 + 8 * c) = o; }
    LDS_WAIT(); asm volatile("" ::: "memory");
}

struct Ptrs {
    float* out; unsigned char* ws;
#define PIN(name, idx) __device__ __forceinline__ const float* name() const { const float* p; auto ka = __builtin_amdgcn_kernarg_segment_ptr(); asm volatile("s_load_dwordx2 %0, %1, " #idx "*8\n\ts_waitcnt lgkmcnt(0)" : "=s"(p) : "s"(ka)); return p; }
    PIN(x, 0) PIN(p, 1) PIN(g_mix, 2) PIN(w_in, 3) PIN(lq1, 4) PIN(lk1, 5) PIN(lq2, 6) PIN(lk2, 7) PIN(g_sb, 8) PIN(g_df, 9) PIN(w_out, 10) PIN(g_ffn, 11) PIN(w_rg, 12) PIN(b_rg, 13) PIN(w_re, 14) PIN(b_re, 15)
    PIN(w_eg, 16) PIN(w_eu, 17) PIN(w_ed, 18) PIN(g_ple, 19) PIN(w_pg, 20) PIN(w_pp, 21) PIN(g_final, 22)
#undef PIN
};

__device__ __forceinline__ void p0_prologue(const Ptrs& P, LAS unsigned char* lds, int gw, int NGW, int lane, int wave) {
    LAS float* scr = (LAS float*)(lds + wave * 16384);
    bf16_t* Win_t = (bf16_t*)(P.ws + WS_WIN); bf16_t* Wout_t = (bf16_t*)(P.ws + WS_WOUT); bf16_t* Wgu_t = (bf16_t*)(P.ws + WS_WGU); bf16_t* Wd_t = (bf16_t*)(P.ws + WS_WD);
    bf16_t* Wpg_t = (bf16_t*)(P.ws + WS_WPG); bf16_t* Wpp_t = (bf16_t*)(P.ws + WS_WPP);
    constexpr int I_IN = 16 * 96, I_OUT = 16 * 32, I_EG = NEXP * 16 * 16, I_ED = NEXP * 8 * 32, I_PG = 16 * 32, I_PP = 4 * 32;
    constexpr int NITEMS = I_IN + I_OUT + 2 * I_EG + I_ED + I_PG + I_PP;
    const float *w_in = P.w_in(), *w_out = P.w_out(), *g_sb = P.g_sb(), *g_df = P.g_df(), *w_eg = P.w_eg(), *w_eu = P.w_eu(), *w_ed = P.w_ed(), *w_pg = P.w_pg(), *g_ple = P.g_ple(), *w_pp = P.w_pp();
    for (int it = gw; it < NITEMS; it += NGW) {
        int r = it;
        if (r < I_IN) { const int kb = r / 96, nb = r % 96; p0_transpose_item(w_in, 1024, 3072, Win_t, kb, nb, 32 * nb, scr, lane, 0, nullptr, nullptr); continue; } r -= I_IN;
        if (r < I_OUT) { const int kb = r / 32, nb = r % 32; p0_transpose_item(w_out, 1024, 1024, Wout_t, kb, nb, 32 * nb, scr, lane, 1, g_sb, g_df); continue; } r -= I_OUT;
        if (r < 2 * I_EG) { const int up = r / I_EG; r -= up * I_EG; const int e = r / 256, q = r % 256, kb = q / 16, nb = q % 16; const int n0 = 32 * nb;
            p0_transpose_item((up ? w_eu : w_eg) + (size_t)e * 1024 * 512, 1024, 512, Wgu_t, kb, nb, e * 1024 + (n0 >> 7) * 256 + up * 128 + (n0 & 127), scr, lane, 0, nullptr, nullptr); continue; } r -= 2 * I_EG;
        if (r < I_ED) { const int e = r / 256, q = r % 256, kb = q / 32, nb = q % 32; p0_transpose_item(w_ed + (size_t)e * 512 * 1024, 512, 1024, Wd_t, kb, nb, e * 1024 + 32 * nb, scr, lane, 0, nullptr, nullptr); continue; } r -= I_ED;
        if (r < I_PG) { const int kb = r / 32, nb = r % 32; p0_transpose_item(w_pg, 1024, 1024, Wpg_t, kb, nb, 32 * nb, scr, lane, 2, g_ple, nullptr); continue; } r -= I_PG;
        { const int kb = r / 32, nb = r % 32; p0_transpose_item(w_pp, 256, 1024, Wpp_t, kb, nb, 32 * nb, scr, lane, 0, nullptr, nullptr); }
    }
    bf16_t* XN = (bf16_t*)(P.ws + WS_XN); bf16_t* PB = (bf16_t*)(P.ws + WS_PB);
    f32x4 gm[4];
#pragma unroll
    for (int j = 0; j < 4; ++j) gm[j] = *((const f32x4*)P.g_mix() + lane + 64 * j);
    const float* xin = P.x(); const float* pin = P.p();
    for (int m = gw; m < NTOK; m += NGW) {
        const f32x4* xr = (const f32x4*)(xin + (size_t)m * DM) + lane;
        f32x4 v[4]; float s = 0.f;
#pragma unroll
        for (int j = 0; j < 4; ++j) { v[j] = xr[64 * j]; s += (v[j].x * v[j].x + v[j].y * v[j].y) + (v[j].z * v[j].z + v[j].w * v[j].w); }
        const float rstd = 1.0f / sqrtf(wave_sum(s) * (1.0f / DM) + EPS);
        unsigned long long* o8 = (unsigned long long*)(XN + (size_t)m * DM) + lane;
#pragma unroll
        for (int j = 0; j < 4; ++j) { const f32x4 y = v[j] * rstd * gm[j]; o8[64 * j] = (unsigned long long)pk2(y.x, y.y) | ((unsigned long long)pk2(y.z, y.w) << 32); }
        const f32x4 pv = *((const f32x4*)(pin + (size_t)m * PLE) + lane);
        *((unsigned long long*)(PB + (size_t)m * PLE) + lane) = (unsigned long long)pk2(pv.x, pv.y) | ((unsigned long long)pk2(pv.z, pv.w) << 32);
    }
}

__device__ __forceinline__ void p4_router(const Ptrs& P, LAS unsigned char* lds, unsigned* ctl, int vb, int nblk, int tid, int lane, int wave) {
    LAS float* WrT = (LAS float*)lds;
    LAS int* st_e = (LAS int*)(lds + 81920); LAS int* st_pos = st_e + 256; LAS int* st_tok = st_pos + 256; LAS float* st_w = (LAS float*)(st_tok + 256);
    LAS unsigned* lcnt = (LAS unsigned*)(st_w + 256); LAS unsigned* lbase = lcnt + 16;
    const float *w_rg = P.w_rg(), *w_re = P.w_re(), *g_ffn = P.g_ffn(), *b_rg = P.b_rg(), *b_re = P.b_re();
    {
        float t[8];
#pragma unroll
        for (int bb = 0; bb < 4; ++bb) {
#pragma unroll
            for (int u = 0; u < 8; ++u) { const int i = tid + 512 * (bb * 8 + u); t[u] = w_re[i] * g_ffn[i >> 4]; }
#pragma unroll
            for (int u = 0; u < 8; ++u) { const int i = tid + 512 * (bb * 8 + u); WrT[(4 + (i & 15)) * 1024 + (i >> 4)] = t[u]; }
        }
#pragma unroll
        for (int u = 0; u < 8; ++u) { const int i = tid + 512 * u; t[u] = w_rg[i] * g_ffn[i >> 2]; }
#pragma unroll
        for (int u = 0; u < 8; ++u) { const int i = tid + 512 * u; WrT[(i & 3) * 1024 + (i >> 2)] = t[u]; }
    }
    bf16_t* H2 = (bf16_t*)(P.ws + WS_XN); int* list = (int*)(P.ws + WS_LIST);
    f32x4 gf[4];
#pragma unroll
    for (int j = 0; j < 4; ++j) gf[j] = *((const f32x4*)g_ffn + lane + 64 * j);
    float bg[4], be[16];
#pragma unroll
    for (int i = 0; i < 4; ++i) bg[i] = b_rg[i];
#pragma unroll
    for (int i = 0; i < 16; ++i) be[i] = b_re[i];
    for (int blk = vb; blk < NTOK / 128; blk += nblk) {
        if (tid < 16) lcnt[tid] = 0u;
        __syncthreads();
        f32x4 na[4], nb[4];
        { const int m0 = blk * 128 + wave * 16;
#pragma unroll
          for (int j = 0; j < 4; ++j) { na[j] = *((const f32x4*)(P.out + (size_t)m0 * DM) + lane + 64 * j); nb[j] = *((const f32x4*)(P.out + (size_t)(m0 + 1) * DM) + lane + 64 * j); } }
        for (int rp = 0; rp < 8; ++rp) {
            const int m0 = blk * 128 + wave * 16 + rp * 2;
            f32x4 va[4], vb4[4]; float sa = 0.f, sb = 0.f;
#pragma unroll
            for (int j = 0; j < 4; ++j) { va[j] = na[j]; vb4[j] = nb[j]; }
            if (rp < 7) {
#pragma unroll
                for (int j = 0; j < 4; ++j) { na[j] = *((const f32x4*)(P.out + (size_t)(m0 + 2) * DM) + lane + 64 * j); nb[j] = *((const f32x4*)(P.out + (size_t)(m0 + 3) * DM) + lane + 64 * j); } }
#pragma unroll
            for (int j = 0; j < 4; ++j) {
                sa += (va[j].x * va[j].x + va[j].y * va[j].y) + (va[j].z * va[j].z + va[j].w * va[j].w); sb += (vb4[j].x * vb4[j].x + vb4[j].y * vb4[j].y) + (vb4[j].z * vb4[j].z + vb4[j].w * vb4[j].w); }
            const float ra = 1.0f / sqrtf(wave_sum(sa) * (1.0f / DM) + EPS), rb = 1.0f / sqrtf(wave_sum(sb) * (1.0f / DM) + EPS);
            { unsigned long long* oa = (unsigned long long*)(H2 + (size_t)m0 * DM) + lane; unsigned long long* ob = (unsigned long long*)(H2 + (size_t)(m0 + 1) * DM) + lane;
#pragma unroll
              for (int j = 0; j < 4; ++j) { const f32x4 ya = va[j] * ra * gf[j], yb = vb4[j] * rb * gf[j];
                  oa[64 * j] = (unsigned long long)pk2(ya.x, ya.y) | ((unsigned long long)pk2(ya.z, ya.w) << 32); ob[64 * j] = (unsigned long long)pk2(yb.x, yb.y) | ((unsigned long long)pk2(yb.z, yb.w) << 32); } }
            float la[20], lb[20];
#pragma unroll
            for (int c = 0; c < 20; ++c) { float a = 0.f, b = 0.f;
#pragma unroll
                for (int j = 0; j < 4; ++j) { const f32x4 w = *((const LAS f32x4*)(WrT + c * 1024) + lane + 64 * j);
                    a += (va[j].x * w.x + va[j].y * w.y) + (va[j].z * w.z + va[j].w * w.w); b += (vb4[j].x * w.x + vb4[j].y * w.y) + (vb4[j].z * w.z + vb4[j].w * w.w); }
                la[c] = wave_sum(a) * ra; lb[c] = wave_sum(b) * rb; }
            float lg[20];
#pragma unroll
            for (int c = 0; c < 20; ++c) lg[c] = (lane == 1 ? lb[c] : la[c]) + (c < 4 ? bg[c] : be[c - 4]);
            int gi = 0; float gmax = lg[0];
#pragma unroll
            for (int i = 1; i < 4; ++i) if (lg[i] > gmax) { gmax = lg[i]; gi = i; }
            float gsum = 0.f;
#pragma unroll
            for (int i = 0; i < 4; ++i) gsum += __expf(lg[i] - gmax);
            const float gwt = 1.0f / gsum;
            float ig[4];
#pragma unroll
            for (int i = 0; i < 4; ++i) ig[i] = gi == 0 ? lg[4 + i] : gi == 1 ? lg[8 + i] : gi == 2 ? lg[12 + i] : lg[16 + i];
            int i0 = 0; float v0 = ig[0];
#pragma unroll
            for (int i = 1; i < 4; ++i) if (ig[i] > v0) { v0 = ig[i]; i0 = i; }
            int i1 = -1; float v1 = -INFINITY;
#pragma unroll
            for (int i = 0; i < 4; ++i) if (i != i0 && (i1 < 0 || ig[i] > v1)) { v1 = ig[i]; i1 = i; }
            const float w0 = 1.0f / (1.0f + __expf(v1 - v0)), w1 = 1.0f - w0;
            if (lane < 2) {
                const int m = m0 + lane, e0 = gi * 4 + i0, e1 = gi * 4 + i1, si = 2 * (wave * 16 + rp * 2 + lane);
                st_e[si] = e0; st_pos[si] = (int)atomicAdd((unsigned*)&lcnt[e0], 1u); st_tok[si] = 2 * m; st_w[si] = w0 * gwt;
                st_e[si + 1] = e1; st_pos[si + 1] = (int)atomicAdd((unsigned*)&lcnt[e1], 1u); st_tok[si + 1] = 2 * m + 1; st_w[si + 1] = w1 * gwt;
            }
        }
        __syncthreads();
        if (tid < 16) lbase[tid] = lcnt[tid] ? __hip_atomic_fetch_add(ctl + CW_CNT + 64 * tid, lcnt[tid], RLX_AGENT) : 0u;
        __syncthreads();
        if (tid < 256) { const int e = st_e[tid]; const size_t slot = (size_t)e * LIST_CAP + lbase[e] + st_pos[tid]; int2 ent; ent.x = st_tok[tid]; ent.y = __float_as_int(st_w[tid]); *(int2*)(list + 2 * slot) = ent; }
        __syncthreads();
    }
}

__device__ __forceinline__ void p7_rows(const Ptrs& P, int gw, int NGW, int lane) {
    bf16_t* H3 = (bf16_t*)(P.ws + WS_XN); const bf16_t* YB = (const bf16_t*)(P.ws + WS_YB);
    for (int m = gw; m < NTOK; m += NGW) {
        f32x4* xr = (f32x4*)(P.out + (size_t)m * DM) + lane;
        const u32x2* y0 = (const u32x2*)(YB + (size_t)(2 * m) * DM) + lane; const u32x2* y1 = (const u32x2*)(YB + (size_t)(2 * m + 1) * DM) + lane;
        f32x4 v[4]; float s = 0.f;
#pragma unroll
        for (int j = 0; j < 4; ++j) { v[j] = xr[64 * j]; const u32x2 a = y0[64 * j], b = y1[64 * j];
            v[j].x += bf_lo(a.x) + bf_lo(b.x); v[j].y += bf_hi(a.x) + bf_hi(b.x); v[j].z += bf_lo(a.y) + bf_lo(b.y); v[j].w += bf_hi(a.y) + bf_hi(b.y);
            s += (v[j].x * v[j].x + v[j].y * v[j].y) + (v[j].z * v[j].z + v[j].w * v[j].w); }
        const float rstd = 1.0f / sqrtf(wave_sum(s) * (1.0f / DM) + EPS);
        unsigned long long* o8 = (unsigned long long*)(H3 + (size_t)m * DM) + lane;
#pragma unroll
        for (int j = 0; j < 4; ++j) { xr[64 * j] = v[j]; const f32x4 y = v[j] * rstd; o8[64 * j] = (unsigned long long)pk2(y.x, y.y) | ((unsigned long long)pk2(y.z, y.w) << 32); }
    }
}
__device__ __forceinline__ void p10_rows(const Ptrs& P, int gw, int NGW, int lane) {
    f32x4 gf[4];
#pragma unroll
    for (int j = 0; j < 4; ++j) gf[j] = *((const f32x4*)P.g_final() + lane + 64 * j);
    for (int m = gw; m < NTOK; m += NGW) {
        f32x4* xr = (f32x4*)(P.out + (size_t)m * DM) + lane;
        f32x4 v[4]; float s = 0.f;
#pragma unroll
        for (int j = 0; j < 4; ++j) { v[j] = xr[64 * j]; s += (v[j].x * v[j].x + v[j].y * v[j].y) + (v[j].z * v[j].z + v[j].w * v[j].w); }
        const float rstd = 1.0f / sqrtf(wave_sum(s) * (1.0f / DM) + EPS);
#pragma unroll
        for (int j = 0; j < 4; ++j) xr[64 * j] = v[j] * rstd * gf[j];
    }
}

enum { PH_PROLOGUE = 0, PH_INPROJ, PH_ATT_SB, PH_ATT_DF, PH_OUTPROJ, PH_ROUTER, PH_GATEUP, PH_DOWN, PH_ROWS_X2, PH_PLE_PROJ, PH_PLE_GATE, PH_FINAL, PH_COUNT };
struct Args { const float* in[23]; float* out; unsigned char* ws; int ph_lo, ph_hi; };
static_assert(sizeof(Args) == 23 * 8 + 16 + 8, "Args has no padding holes");
__global__ void __launch_bounds__(NWAVES * 64, 2) hymba_fwd(Args args) {
    extern __shared__ __attribute__((aligned(16))) unsigned char lds_raw[];
    LAS unsigned char* lds = (LAS unsigned char*)lds_raw;
    volatile LAS unsigned* MISC = (volatile LAS unsigned*)(lds + MISC_OFF);
    const int wave = fresh_wave();
    const int G = gridDim.x; const int bx = blockIdx.x; const int vcu = (G % 8 == 0) ? (bx % 8) * (G / 8) + bx / 8 : bx;
    Ptrs P; P.out = args.out; P.ws = args.ws;
    unsigned* ctl = (unsigned*)(args.ws + WS_CTL);
    for (int u = threadIdx.x; u < (LDS_BYTES - LDSCTL_OFF) / 4; u += NWAVES * 64) ((LAS unsigned*)(lds + LDSCTL_OFF))[u] = 0u;
    __syncthreads();
    const int lo = args.ph_lo, hi = args.ph_hi;
    XcdBarrier bar; bar.bar = ctl + CW_BAR; bar.x = 0; bar.st = nullptr;
    if (hi - lo > 1) bar = xcd_barrier_post(ctl + CW_BAR, MISC + 8);
#define IN(k) (lo <= (k) && (k) < hi)
#define SEAM(k) do { if (IN(k) && IN((k) + 1)) xcd_barrier(bar); } while (0)
    const int gw = vcu * NWAVES + wave, NGW = G * NWAVES;
    bf16_t* XN = (bf16_t*)(args.ws + WS_XN); bf16_t* QKV = (bf16_t*)(args.ws + WS_QKV); bf16_t* OB = (bf16_t*)(args.ws + WS_OB);

    if (IN(PH_PROLOGUE)) { p0_prologue(P, lds, gw, NGW, fresh_lane(), wave); }
    SEAM(PH_PROLOGUE);
    if (IN(PH_INPROJ)) {
        pg8::Gemm g{XN, (const bf16_t*)(args.ws + WS_WIN), 1024, nullptr, 0}; pg8::StaticOrder S; S.init(NTOK, NQKV, G, bx);
        pg8::EpiQKV E{QKV};
        pg8::gemm_phase<pg8::EpiQKV, pg8::StaticOrder, false>(lds, g, S, E);
    }
    SEAM(PH_INPROJ);
    if (IN(PH_ATT_SB)) {
        char* shm = (char*)lds_raw;
        for (int i = 0; i < 4; ++i) { const int u = vcu * 4 + i; if (u < BATCH * 128) att::sb_unit(u >> 7, u & 127, i & 1, QKV, OB, shm); }
        __syncthreads();
    }
    if (IN(PH_ATT_DF)) {
        char* shm = (char*)lds_raw;
        const int lane = fresh_lane();
        float d1 = P.lq1()[lane] * P.lk1()[lane], d2 = P.lq2()[lane] * P.lk2()[lane];
        const float lam = __expf(wave_sum(d1)) - __expf(wave_sum(d2)) + LAMBDA_INIT;
        if (vcu < 256) {
            const int bh = vcu >> 3, s = vcu & 7, b = bh >> 2, h = bh & 3;
            const float slope2 = exp2f(-2.0f * (float)(h + 1)) * LOG2E;
            for (int i = 0; i < 4; ++i) { const int qb = (i == 0) ? s : (i == 1) ? 31 - s : (i == 2) ? 15 - s : 16 + s; att::df_unit(b, h, qb, QKV, OB, shm, lam, slope2); }
        }
    }
    SEAM(PH_ATT_DF);
    if (IN(PH_OUTPROJ)) {
        pg8::Gemm g{OB, (const bf16_t*)(args.ws + WS_WOUT), 1024, nullptr, 0}; pg8::StaticOrder S; S.init(NTOK, DM, G, bx);
        pg8::EpiResF32 E{P.x(), P.out};
        pg8::gemm_phase<pg8::EpiResF32, pg8::StaticOrder, false>(lds, g, S, E);
    }
    SEAM(PH_OUTPROJ);
    if (IN(PH_ROUTER)) { const int lane = fresh_lane(); p4_router(P, lds, ctl, vcu, G, wave * 64 + lane, lane, wave); }
    SEAM(PH_ROUTER);
    if (IN(PH_GATEUP)) {
        pg8::Gemm g{XN, (const bf16_t*)(args.ws + WS_WGU), 1024, (const int*)(args.ws + WS_LIST), 0}; pg8::GroupedOrder S; S.init(ctl + CW_CNT, (LAS int*)(lds + LDSCTL_OFF), G, bx, 1, 1024);
        pg8::EpiSwiGLU E{(bf16_t*)(args.ws + WS_HID)};
        pg8::gemm_phase<pg8::EpiSwiGLU, pg8::GroupedOrder, true>(lds, g, S, E);
    }
    SEAM(PH_GATEUP);
    if (IN(PH_DOWN)) {
        pg8::Gemm g{(const bf16_t*)(args.ws + WS_HID), (const bf16_t*)(args.ws + WS_WD), 512, nullptr, 0}; pg8::GroupedOrder S; S.init(ctl + CW_CNT, (LAS int*)(lds + LDSCTL_OFF + 64), G, bx, 0, 1024);
        pg8::EpiDown E{(bf16_t*)(args.ws + WS_YB), (const int*)(args.ws + WS_LIST)};
        pg8::gemm_phase<pg8::EpiDown, pg8::GroupedOrder, false>(lds, g, S, E);
    }
    SEAM(PH_DOWN);
    if (IN(PH_ROWS_X2)) { p7_rows(P, gw, NGW, fresh_lane()); }
    SEAM(PH_ROWS_X2);
    if (IN(PH_PLE_PROJ)) {
        pg8::Gemm g{(const bf16_t*)(args.ws + WS_PB), (const bf16_t*)(args.ws + WS_WPP), 256, nullptr, 0}; pg8::StaticOrder S; S.init(NTOK, DM, G, bx);
        pg8::EpiBf16 E{(bf16_t*)(args.ws + WS_PP), DM};
        pg8::gemm_phase<pg8::EpiBf16, pg8::StaticOrder, false>(lds, g, S, E);
    }
    SEAM(PH_PLE_PROJ);
    if (IN(PH_PLE_GATE)) {
        pg8::Gemm g{XN, (const bf16_t*)(args.ws + WS_WPG), 1024, nullptr, 0}; pg8::StaticOrder S; S.init(NTOK, DM, G, bx);
        pg8::EpiPle E{P.out, (const bf16_t*)(args.ws + WS_PP)};
        pg8::gemm_phase<pg8::EpiPle, pg8::StaticOrder, false>(lds, g, S, E);
    }
    SEAM(PH_PLE_GATE);
    if (IN(PH_FINAL)) { p10_rows(P, gw, NGW, fresh_lane()); }
#undef IN
#undef SEAM
}

#ifndef PROBE_REPEAT
#define PROBE_REPEAT -1
#endif
extern "C" void kernel_launch(void* const* d_in, const int* in_sizes, int n_in, void* d_out, int out_size, void* d_ws, size_t ws_size, hipStream_t stream) {
    static int grid = 0;
    if (grid == 0) {
        if (n_in != 23 || in_sizes[0] != NTOK * DM || out_size != NTOK * DM || ws_size < WS_END) { fprintf(stderr, "kernel_launch: unexpected shapes (n_in %d, in0 %d, out %d, ws %zu; need ws >= %zu); nothing launched\n", n_in, n_in > 0 ? in_sizes[0] : -1, out_size, ws_size, (size_t)WS_END); grid = -1; return; }
        int dev = 0, cus = 0, per_cu = 0;
        if (hipGetDevice(&dev) != hipSuccess || hipDeviceGetAttribute(&cus, hipDeviceAttributeMultiprocessorCount, dev) != hipSuccess) { fprintf(stderr, "kernel_launch: device query failed\n"); grid = -1; return; }
        if (hipFuncSetAttribute((const void*)hymba_fwd, hipFuncAttributeMaxDynamicSharedMemorySize, LDS_BYTES) != hipSuccess) { fprintf(stderr, "kernel_launch: hipFuncSetAttribute failed\n"); grid = -1; return; }
        if (hipOccupancyMaxActiveBlocksPerMultiprocessor(&per_cu, (const void*)hymba_fwd, NWAVES * 64, LDS_BYTES) != hipSuccess || per_cu < 1) { fprintf(stderr, "kernel_launch: occupancy query says %d blocks per CU; nothing launched\n", per_cu); (void)hipGetLastError(); grid = -1; return; }
        grid = cus;
        fprintf(stderr, "kernel_launch: %d CUs, occupancy %d/CU, grid %d\n", cus, per_cu, grid);
    }
    if (grid < 0) return;
    if (hipMemsetAsync((char*)d_ws + WS_CTL, 0, CTL_ZERO_BYTES, stream) != hipSuccess) { fprintf(stderr, "kernel_launch: memset failed\n"); return; }
    Args a{};
    for (int i = 0; i < 23; ++i) a.in[i] = (const float*)d_in[i];
    a.out = (float*)d_out; a.ws = (unsigned char*)d_ws;
#if MK_N_LAUNCHES == 1
    a.ph_lo = 0; a.ph_hi = PH_COUNT;
    void* kargs[] = {&a};
    hipError_t e = hipLaunchCooperativeKernel((const void*)hymba_fwd, dim3(grid), dim3(NWAVES * 64), kargs, LDS_BYTES, stream);
    if (e != hipSuccess) fprintf(stderr, "kernel_launch: cooperative launch failed: %s (grid %d)\n", hipGetErrorString(e), grid);
#else
    for (int li = 0; li < PH_COUNT; ++li) {
        a.ph_lo = li; a.ph_hi = li + 1;
        for (int r = 0; r < (li == PROBE_REPEAT ? 2 : 1); ++r) { if (r == 1 && li == PH_ROUTER) (void)hipMemsetAsync((char*)d_ws + WS_CTL, 0, CTL_ZERO_BYTES, stream); hipLaunchKernelGGL(hymba_fwd, dim3(grid), dim3(NWAVES * 64), LDS_BYTES, stream, a); }
    }
#endif
}
```

```cpp
#include <hip/hip_runtime.h>
#include <hip/hip_bf16.h>
#include <cstdio>
#include <cstdint>

#ifndef MK_N_LAUNCHES
#define MK_N_LAUNCHES 1
#endif

#define LAS __attribute__((address_space(3)))
#define GAS __attribute__((address_space(1)))
typedef unsigned short bf16_t;
typedef short bf16x8 __attribute__((ext_vector_type(8)));
typedef short s16x4 __attribute__((ext_vector_type(4)));
typedef float f32x4 __attribute__((ext_vector_type(4)));
typedef float f32x2 __attribute__((ext_vector_type(2)));
typedef float f32x16 __attribute__((ext_vector_type(16)));
typedef unsigned u32x4 __attribute__((ext_vector_type(4)));
typedef unsigned u32x2 __attribute__((ext_vector_type(2)));

constexpr int BATCH = 8, SEQ = 4096, DM = 1024, NTOK = BATCH * SEQ;
constexpr int NQKV = 3072;
constexpr int COL_QSB = 0, COL_KSB = 512, COL_VSB = 1024, COL_QDF = 1536, COL_KDF = 2048, COL_VDF = 2560;
constexpr int NEXP = 16, DEXP = 512, PLE = 256;
constexpr float EPS = 1e-6f;
constexpr float LOG2E = 1.4426950408889634f;
constexpr float C2 = 0.125f * LOG2E;
constexpr float LAMBDA_INIT = 0.2f;
constexpr int LIST_CAP = NTOK;
constexpr int HID_ROWS = 2 * NTOK + NEXP * 256;

constexpr size_t MiB = 1u << 20;
constexpr size_t WS_CTL = 0, CTL_ZERO_BYTES = 1 * MiB;
constexpr size_t WS_WIN = 1 * MiB;
constexpr size_t WS_WOUT = 7 * MiB;
constexpr size_t WS_WGU = 9 * MiB;
constexpr size_t WS_WD = 41 * MiB;
constexpr size_t WS_WPG = 57 * MiB;
constexpr size_t WS_WPP = 59 * MiB;
constexpr size_t WS_LIST = 60 * MiB;
constexpr size_t WS_XN = 64 * MiB;
constexpr size_t WS_PB = 128 * MiB;
constexpr size_t WS_QKV = 144 * MiB;
constexpr size_t WS_HID = 144 * MiB;
constexpr size_t WS_X2B = 144 * MiB;
constexpr size_t WS_PP = 212 * MiB;
constexpr size_t WS_OB = 336 * MiB;
constexpr size_t WS_YB = 336 * MiB;
constexpr size_t WS_RSTD2 = 464 * MiB;
constexpr size_t WS_RSTD3 = 464 * MiB + 131072;
constexpr size_t WS_END = 465 * MiB;
static_assert(WS_HID + (size_t)HID_ROWS * DEXP * 2 <= WS_PP && WS_PP + (size_t)NTOK * DM * 2 <= WS_QKV + (size_t)NTOK * NQKV * 2, "overlay map");
constexpr int CW_TMO = 0, CW_CODE = 1;
constexpr int CW_BAR = 4096;
constexpr int CW_CNT = 8192;

constexpr int RING_BYTES = 131072;
constexpr int LDSCTL_OFF = RING_BYTES, MISC_OFF = LDSCTL_OFF + 320;
constexpr int LDS_BYTES = 147456;
constexpr int NWAVES = 8;

#define RLX_AGENT __ATOMIC_RELAXED, __HIP_MEMORY_SCOPE_AGENT
#define LDS_WAIT() asm volatile("s_waitcnt lgkmcnt(0)" ::: "memory")
#define VM_WAIT() asm volatile("s_waitcnt vmcnt(0)" ::: "memory")
__device__ __forceinline__ unsigned cvt_pk_bf16(float lo, float hi) { unsigned r; asm volatile("v_cvt_pk_bf16_f32 %0, %1, %2" : "=v"(r) : "v"(lo), "v"(hi)); return r; }
__device__ __forceinline__ float bf_lo(unsigned u) { return __uint_as_float(u << 16); }
__device__ __forceinline__ float bf_hi(unsigned u) { return __uint_as_float(u & 0xffff0000u); }
__device__ __forceinline__ float wave_sum(float v) {
    v += __builtin_bit_cast(float, __builtin_amdgcn_update_dpp(0, __builtin_bit_cast(int, v), 0xB1, 0xF, 0xF, true));
    v += __builtin_bit_cast(float, __builtin_amdgcn_update_dpp(0, __builtin_bit_cast(int, v), 0x4E, 0xF, 0xF, true));
    v += __builtin_bit_cast(float, __builtin_amdgcn_update_dpp(0, __builtin_bit_cast(int, v), 0x141, 0xF, 0xF, true));
    v += __builtin_bit_cast(float, __builtin_amdgcn_update_dpp(0, __builtin_bit_cast(int, v), 0x140, 0xF, 0xF, true));
    { auto rr = __builtin_amdgcn_permlane16_swap(__float_as_uint(v), __float_as_uint(v), false, false); v = __uint_as_float(rr[0]) + __uint_as_float(rr[1]); }
    { auto rr = __builtin_amdgcn_permlane32_swap(__float_as_uint(v), __float_as_uint(v), false, false); v = __uint_as_float(rr[0]) + __uint_as_float(rr[1]); }
    return v;
}
__device__ __forceinline__ int fresh_lane() { int l; asm volatile("v_mbcnt_lo_u32_b32 %0, -1, 0\n\tv_mbcnt_hi_u32_b32 %0, -1, %0" : "=v"(l)); return l; }
__device__ __forceinline__ int fresh_wave() { return __builtin_amdgcn_readfirstlane((int)threadIdx.x >> 6); }
__device__ __forceinline__ float fast_rcp(float x) { return __builtin_amdgcn_rcpf(x); }
__device__ __forceinline__ float fast_exp2(float x) { return __builtin_amdgcn_exp2f(x); }
__device__ __forceinline__ float fast_log2(float x) { return __builtin_amdgcn_logf(x); }
__device__ __forceinline__ float sigmoidf_(float x) { return fast_rcp(1.0f + fast_exp2(-x * LOG2E)); }

namespace pg8 {
constexpr int BM = 256, BK = 64, HALF = 128, HTB = HALF * BK * 2, STAGE_BYTES = 8 * HTB, NXCD = 8, WGM = 8;
__host__ __device__ __forceinline__ int lds_byte(int r, int c) { const int st = (r >> 4) * 2 + (c >> 5), rr = r & 15, cc = c & 31, ob = rr * 64 + cc * 2; return st * 1024 + (ob ^ (((ob >> 9) & 1) << 5)); }
__host__ __device__ __forceinline__ void stage_rc(int b, int& R, int& C) { const int st = b / 1024, sb = b % 1024, swz = sb ^ (((sb >> 9) & 1) << 5); R = (st >> 1) * 16 + swz / 64; C = (st & 1) * 32 + (swz % 64) / 2; }
__host__ __device__ __forceinline__ int perm32(int rho) { const int n = rho >> 4, i = rho & 15; return 8 * (i >> 2) + 4 * n + (i & 3); }

struct Unit { int pm, pn, arow, brow, e, valid, lrow; };
struct Gemm { const bf16_t* A; const bf16_t* Bt; int K; const int* gidx; int gcap; };

struct StaticOrder {
    int nM, nN, nwg, G, c;
    __device__ void init(int M, int N, int G_, int c_) { nM = M / BM; nN = N / BM; nwg = nM * nN; G = G_; c = c_; }
    __device__ bool next(int i, Unit& u) const {
        const long L = (long)i * G + c; if (L >= nwg) return false;
        int wgid = (int)L; { const int q = nwg / NXCD, r = nwg % NXCD, xcd = wgid % NXCD, off = wgid / NXCD; wgid = (xcd < r ? xcd * (q + 1) : r * (q + 1) + (xcd - r) * q) + off; }
        const int nig = WGM * nN, gid = wgid / nig, fm = gid * WGM, gsz = (nM - fm) < WGM ? (nM - fm) : WGM;
        u.pm = fm + ((wgid % nig) % gsz); u.pn = (wgid % nig) / gsz; u.arow = u.pm * BM; u.brow = u.pn * BM; u.e = 0; u.valid = BM; u.lrow = 0; return true;
    }
};
struct GroupedOrder {
    const LAS int* cnt; int nwg, G, c; int listmode;
    int nbrow;
    __device__ void init(const unsigned* gcnt, LAS int* lcnt, int G_, int c_, int listmode_, int nbrow_) {
        { const int t_ = fresh_wave() * 64 + fresh_lane(); if (t_ < NEXP) lcnt[t_] = (int)__hip_atomic_load(gcnt + 64 * t_, RLX_AGENT); }
        __syncthreads();
        int tot = 0;
#pragma unroll
        for (int e = 0; e < NEXP; ++e) tot += (lcnt[e] + 255) >> 8;
        cnt = lcnt; nwg = __builtin_amdgcn_readfirstlane(tot * 4); G = G_; c = c_; listmode = listmode_; nbrow = nbrow_;
    }
    __device__ bool next(int i, Unit& u) const {
        const long L = (long)i * G + c; if (L >= nwg) return false;
        int wgid = (int)L; { const int q = nwg / NXCD, r = nwg % NXCD, xcd = wgid % NXCD, off = wgid / NXCD; wgid = (xcd < r ? xcd * (q + 1) : r * (q + 1) + (xcd - r) * q) + off; }
        int tile = wgid >> 2; const int pn = wgid & 3;
        int e = 0, hoff = 0, found = 0, mt = 0, hh = 0, ce = 0;
        for (int k = 0; k < NEXP; ++k) { const int ck = __builtin_amdgcn_readfirstlane(cnt[k]); const int tl = (ck + 255) >> 8; if (!found) { if (tile < tl) { found = 1; e = k; mt = tile; hh = hoff; ce = ck; } else { tile -= tl; hoff += tl; } } }
        u.e = e; u.pn = pn; u.pm = hh + mt;
        u.lrow = e * LIST_CAP + mt * BM;
        u.arow = listmode ? u.lrow : (hh + mt) * BM;
        u.brow = e * nbrow + pn * BM;
        const int rem = ce - mt * BM; u.valid = rem < BM ? rem : BM;
        return true;
    }
};

template <class Epi, class Sched, bool GATHER>
__device__ __forceinline__ void gemm_phase(LAS unsigned char* lds, const Gemm g, const Sched& S, const Epi& E) {
    const int wid = fresh_wave(), lane = fresh_lane(), tid = wid * 64 + lane, wr = wid >> 2, wc = wid & 3, fr = lane & 15, fq = lane >> 4;
    const int K = g.K, nt = K / BK;
    unsigned voffA[2], voffB[2]; int RA[2], CA;
#pragma unroll
    for (int i = 0; i < 2; ++i) { int R, C; stage_rc(tid * 16 + i * 8192, R, C); const int Rb = Epi::PERM ? ((R & ~31) + perm32(R & 31)) : R;
        voffA[i] = (unsigned)(R * K + C) * 2u; voffB[i] = (unsigned)(Rb * K + C) * 2u; RA[i] = R; CA = C; }
    const size_t kstep = (size_t)(BK * 2);
    const size_t hstep = (size_t)HALF * K * 2;
    const unsigned ldsw = (unsigned)wid * 1024u;
    const int aoff = lds_byte(wr * 64 + fr, fq * 8), boff = lds_byte(wc * 32 + fr, fq * 8);
#define PG8_SA(b, h) (((b) * 2 + (h)) * HTB)
#define PG8_SB(b, h) ((4 + (b) * 2 + (h)) * HTB)
#define PG8_STAGE(bufoff, gbase, voff) do { _Pragma("unroll") for (int _i = 0; _i < 2; ++_i) \
        __builtin_amdgcn_global_load_lds((const unsigned*)((const char*)(gbase) + (voff)[_i]), (LAS unsigned*)(lds + (bufoff) + ldsw + _i * 8192), 16, 0, 0); } while (0)
#define PG8_STAGE2(bufoff, gbase, v0, v1) do { \
        __builtin_amdgcn_global_load_lds((const unsigned*)((const char*)(gbase) + (v0)), (LAS unsigned*)(lds + (bufoff) + ldsw), 16, 0, 0); \
        __builtin_amdgcn_global_load_lds((const unsigned*)((const char*)(gbase) + (v1)), (LAS unsigned*)(lds + (bufoff) + ldsw + 8192), 16, 0, 0); } while (0)
#define PG8_LDA(dst, b, h) do { _Pragma("unroll") for (int m = 0; m < 4; ++m) _Pragma("unroll") for (int k = 0; k < 2; ++k) dst[m][k] = *(const LAS bf16x8*)(lds + PG8_SA(b, h) + aoff + m * 2048 + k * 1024); } while (0)
#define PG8_LDB(dst, b, h) do { _Pragma("unroll") for (int n = 0; n < 2; ++n) _Pragma("unroll") for (int k = 0; k < 2; ++k) dst[n][k] = *(const LAS bf16x8*)(lds + PG8_SB(b, h) + boff + n * 2048 + k * 1024); } while (0)
#define PG8_MMA(ai, bj, At, Bt) do { __builtin_amdgcn_s_setprio(1); _Pragma("unroll") for (int m = 0; m < 4; ++m) _Pragma("unroll") for (int n = 0; n < 2; ++n) _Pragma("unroll") for (int k = 0; k < 2; ++k) \
        acc[ai][bj][m][n] = __builtin_amdgcn_mfma_f32_16x16x32_bf16(Bt[n][k], At[m][k], acc[ai][bj][m][n], 0, 0, 0); __builtin_amdgcn_s_setprio(0); } while (0)
#define PG8_WAIT_V(n) asm volatile("s_waitcnt vmcnt(" #n ")" ::: "memory")
#define PG8_WAIT_L(n) asm volatile("s_waitcnt lgkmcnt(" #n ")" ::: "memory")
#define PG8_BAR __builtin_amdgcn_s_barrier()
#define PG8_SCHED __builtin_amdgcn_sched_barrier(0)
#define PG8_GOFF(dst, u) do { _Pragma("unroll") for (int _h = 0; _h < 2; ++_h) _Pragma("unroll") for (int _i = 0; _i < 2; ++_i) { const int _r = _h * HALF + RA[_i]; int _tok = 0; \
        if (_r < (u).valid) _tok = g.gidx[2 * ((u).arow + _r)] >> 1; dst[_h][_i] = (unsigned)(_tok * K + CA) * 2u; } } while (0)
    Unit cur, nxt; int ui = 0;
    if (!S.next(0, cur)) return;
    f32x4 acc[2][2][4][2];
#pragma unroll
    for (int a = 0; a < 2; ++a)
#pragma unroll
        for (int b = 0; b < 2; ++b)
#pragma unroll
            for (int m = 0; m < 4; ++m)
#pragma unroll
                for (int n = 0; n < 2; ++n) acc[a][b][m][n] = (f32x4){0.f, 0.f, 0.f, 0.f};
    bf16x8 At[4][2], B0[2][2], B1[2][2];
    unsigned gc[2][2], gn[2][2];
    const char* cA; const char* cB = (const char*)g.Bt + (size_t)cur.brow * K * 2;
    if constexpr (GATHER) { cA = (const char*)g.A; PG8_GOFF(gc, cur); } else { cA = (const char*)g.A + (size_t)cur.arow * K * 2; }
#define PG8_STA(bufoff, ab, ko, go, h) do { if constexpr (GATHER) { PG8_STAGE2(bufoff, (ab) + (ko), go[h][0], go[h][1]); } else { PG8_STAGE(bufoff, (ab) + (ko) + (h) * hstep, voffA); } } while (0)
    PG8_STAGE(PG8_SB(0, 0), cB, voffB); PG8_STAGE(PG8_SB(0, 1), cB + hstep, voffB); PG8_STA(PG8_SA(0, 0), cA, 0, gc, 0); PG8_STA(PG8_SA(0, 1), cA, 0, gc, 1);
    if (wr == 1) PG8_BAR;
    PG8_WAIT_V(2); PG8_BAR;
    PG8_STAGE(PG8_SB(1, 0), cB + kstep, voffB); PG8_STA(PG8_SA(1, 0), cA, kstep, gc, 0); PG8_STAGE(PG8_SB(1, 1), cB + hstep + kstep, voffB);
    PG8_WAIT_V(6); PG8_BAR;
    for (;;) {
        const bool has_next = S.next(ui + 1, nxt);
        const char* nA; const char* nB = has_next ? (const char*)g.Bt + (size_t)nxt.brow * K * 2 : cB;
        if constexpr (GATHER) { nA = cA; if (has_next) { PG8_GOFF(gn, nxt); } else {
#pragma unroll
            for (int h = 0; h < 2; ++h)
#pragma unroll
                for (int i = 0; i < 2; ++i) gn[h][i] = gc[h][i]; } }
        else { nA = has_next ? (const char*)g.A + (size_t)nxt.arow * K * 2 : cA; }
        for (int t = 0; t < nt; t += 2) {
            const bool last = (t == nt - 2);
            const size_t k1 = (size_t)(t + 1) * kstep;
            const char* a2 = last ? nA : cA; const size_t k2 = last ? 0 : (size_t)(t + 2) * kstep; const char* b2 = last ? nB : cB + (size_t)(t + 2) * kstep;
            const char* b3 = b2 + kstep; const size_t k3 = k2 + kstep;
            unsigned g2[2][2];
            if constexpr (GATHER) {
#pragma unroll
                for (int h = 0; h < 2; ++h)
#pragma unroll
                    for (int i = 0; i < 2; ++i) g2[h][i] = last ? gn[h][i] : gc[h][i]; }
            PG8_LDB(B0, 0, 0); PG8_LDB(B1, 0, 1); PG8_SCHED; PG8_LDA(At, 0, 0); PG8_STA(PG8_SA(1, 1), cA, k1, gc, 1);
            PG8_WAIT_V(8); PG8_WAIT_L(0); PG8_BAR; PG8_MMA(0, 0, At, B0); PG8_MMA(0, 1, At, B1); PG8_BAR; PG8_SCHED;
            PG8_LDA(At, 0, 1); PG8_STAGE(PG8_SB(0, 0), b2, voffB); PG8_STAGE(PG8_SB(0, 1), b2 + hstep, voffB); PG8_STA(PG8_SA(0, 0), a2, k2, g2, 0);
            PG8_WAIT_V(8); PG8_WAIT_L(0); PG8_BAR; PG8_MMA(1, 0, At, B0); PG8_MMA(1, 1, At, B1); PG8_BAR; PG8_SCHED;
            PG8_LDB(B0, 1, 0); PG8_LDB(B1, 1, 1); PG8_SCHED; PG8_LDA(At, 1, 0); PG8_STA(PG8_SA(0, 1), a2, k2, g2, 1);
            PG8_WAIT_V(8); PG8_WAIT_L(0); PG8_BAR; PG8_MMA(0, 0, At, B0); PG8_MMA(0, 1, At, B1); PG8_BAR; PG8_SCHED;
            PG8_LDA(At, 1, 1); PG8_STAGE(PG8_SB(1, 0), b3, voffB); PG8_STAGE(PG8_SB(1, 1), b3 + hstep, voffB); PG8_STA(PG8_SA(1, 0), a2, k3, g2, 0);
            PG8_WAIT_V(8); PG8_WAIT_L(0); PG8_BAR; PG8_MMA(1, 0, At, B0); PG8_MMA(1, 1, At, B1); PG8_BAR; PG8_SCHED;
        }
        if (wr == 0) PG8_BAR;
        E(acc, cur, wr, wc, fr, fq);
        if (!has_next) break;
#pragma unroll
        for (int a = 0; a < 2; ++a)
#pragma unroll
            for (int b = 0; b < 2; ++b)
#pragma unroll
                for (int m = 0; m < 4; ++m)
#pragma unroll
                    for (int n = 0; n < 2; ++n) acc[a][b][m][n] = (f32x4){0.f, 0.f, 0.f, 0.f};
        cur = nxt; cA = nA; cB = nB; ++ui;
        if constexpr (GATHER) {
#pragma unroll
            for (int h = 0; h < 2; ++h)
#pragma unroll
                for (int i = 0; i < 2; ++i) gc[h][i] = gn[h][i]; }
        if (wr == 1) PG8_BAR;
    }
    PG8_WAIT_V(0);
    PG8_BAR;
#undef PG8_SA
#undef PG8_SB
#undef PG8_STAGE
#undef PG8_STAGE2
#undef PG8_STA
#undef PG8_GOFF
#undef PG8_LDA
#undef PG8_LDB
#undef PG8_MMA
#undef PG8_WAIT_V
#undef PG8_WAIT_L
#undef PG8_BAR
#undef PG8_SCHED
}

struct EpiQKV {
    static constexpr bool PERM = true;
    bf16_t* O;
    __device__ __forceinline__ void operator()(const f32x4 (&acc)[2][2][4][2], const Unit& u, int wr, int wc, int fr, int fq) const {
        const int row0 = u.pm * BM + wr * 64 + fr, col0 = u.pn * BM + wc * 32 + 8 * fq;
        const float sc = (u.pn < 2 || (u.pn >= 6 && u.pn < 8)) ? C2 : 1.0f;
#pragma unroll
        for (int ai = 0; ai < 2; ++ai)
#pragma unroll
            for (int m = 0; m < 4; ++m) { bf16_t* rowp = O + (size_t)(row0 + ai * HALF + m * 16) * NQKV + col0;
#pragma unroll
                for (int bj = 0; bj < 2; ++bj) { const f32x4 v0 = acc[ai][bj][m][0] * sc, v1 = acc[ai][bj][m][1] * sc;
                    u32x4 w; w.x = cvt_pk_bf16(v0[0], v0[1]); w.y = cvt_pk_bf16(v0[2], v0[3]); w.z = cvt_pk_bf16(v1[0], v1[1]); w.w = cvt_pk_bf16(v1[2], v1[3]);
                    *(u32x4*)(rowp + bj * HALF) = w; } }
    }
};
struct EpiBf16 {
    static constexpr bool PERM = true;
    bf16_t* O; int ldc;
    __device__ __forceinline__ void operator()(const f32x4 (&acc)[2][2][4][2], const Unit& u, int wr, int wc, int fr, int fq) const {
        const int row0 = u.pm * BM + wr * 64 + fr, col0 = u.pn * BM + wc * 32 + 8 * fq;
#pragma unroll
        for (int ai = 0; ai < 2; ++ai)
#pragma unroll
            for (int m = 0; m < 4; ++m) { bf16_t* rowp = O + (size_t)(row0 + ai * HALF + m * 16) * ldc + col0;
#pragma unroll
                for (int bj = 0; bj < 2; ++bj) { const f32x4 v0 = acc[ai][bj][m][0], v1 = acc[ai][bj][m][1];
                    u32x4 w; w.x = cvt_pk_bf16(v0[0], v0[1]); w.y = cvt_pk_bf16(v0[2], v0[3]); w.z = cvt_pk_bf16(v1[0], v1[1]); w.w = cvt_pk_bf16(v1[2], v1[3]);
                    *(u32x4*)(rowp + bj * HALF) = w; } }
    }
};
struct EpiResBf16 {
    static constexpr bool PERM = true;
    const float* base; bf16_t* out;
    __device__ __forceinline__ void operator()(const f32x4 (&acc)[2][2][4][2], const Unit& u, int wr, int wc, int fr, int fq) const {
        const int row0 = u.pm * BM + wr * 64 + fr, col0 = u.pn * BM + wc * 32 + 8 * fq;
#pragma unroll
        for (int ai = 0; ai < 2; ++ai)
#pragma unroll
            for (int m = 0; m < 4; ++m) { const size_t off = (size_t)(row0 + ai * HALF + m * 16) * DM + col0;
#pragma unroll
                for (int bj = 0; bj < 2; ++bj) { const f32x4 b0 = *(const f32x4*)(base + off + bj * HALF), b1 = *(const f32x4*)(base + off + bj * HALF + 4);
                    const f32x4 v0 = b0 + acc[ai][bj][m][0], v1 = b1 + acc[ai][bj][m][1];
                    u32x4 w; w.x = cvt_pk_bf16(v0[0], v0[1]); w.y = cvt_pk_bf16(v0[2], v0[3]); w.z = cvt_pk_bf16(v1[0], v1[1]); w.w = cvt_pk_bf16(v1[2], v1[3]);
                    *(u32x4*)(out + off + bj * HALF) = w; } }
    }
};
struct EpiSwiGLU {
    static constexpr bool PERM = true;
    bf16_t* O; const int* list; const float* rstd;
    __device__ __forceinline__ void operator()(const f32x4 (&acc)[2][2][4][2], const Unit& u, int wr, int wc, int fr, int fq) const {
        const int r0 = wr * 64 + fr, row0 = u.pm * BM + r0, col0 = u.pn * HALF + wc * 32 + 8 * fq;
#pragma unroll
        for (int ai = 0; ai < 2; ++ai)
#pragma unroll
            for (int m = 0; m < 4; ++m) { bf16_t* rowp = O + (size_t)(row0 + ai * HALF + m * 16) * DEXP + col0;
                const int r = r0 + ai * HALF + m * 16; float rs = 0.f;
                if (r < u.valid) rs = rstd[list[2 * (size_t)(u.lrow + r)] >> 1];
                float h[8];
#pragma unroll
                for (int n = 0; n < 2; ++n)
#pragma unroll
                    for (int j = 0; j < 4; ++j) { const float gt = acc[ai][0][m][n][j] * rs, up = acc[ai][1][m][n][j] * rs; h[4 * n + j] = gt * sigmoidf_(gt) * up; }
                u32x4 w; w.x = cvt_pk_bf16(h[0], h[1]); w.y = cvt_pk_bf16(h[2], h[3]); w.z = cvt_pk_bf16(h[4], h[5]); w.w = cvt_pk_bf16(h[6], h[7]);
                *(u32x4*)rowp = w; }
    }
};
struct EpiDown {
    static constexpr bool PERM = true;
    bf16_t* O; const int* list;
    __device__ __forceinline__ void operator()(const f32x4 (&acc)[2][2][4][2], const Unit& u, int wr, int wc, int fr, int fq) const {
        const int r0 = wr * 64 + fr, col0 = u.pn * BM + wc * 32 + 8 * fq;
#pragma unroll
        for (int ai = 0; ai < 2; ++ai)
#pragma unroll
            for (int m = 0; m < 4; ++m) { const int r = r0 + ai * HALF + m * 16;
                if (r < u.valid) { const int2 ent = *(const int2*)(list + 2 * (size_t)(u.lrow + r)); const float w = __int_as_float(ent.y);
                    bf16_t* rowp = O + (size_t)ent.x * DM + col0;
#pragma unroll
                    for (int bj = 0; bj < 2; ++bj) { const f32x4 v0 = acc[ai][bj][m][0] * w, v1 = acc[ai][bj][m][1] * w;
                        u32x4 q; q.x = cvt_pk_bf16(v0[0], v0[1]); q.y = cvt_pk_bf16(v0[2], v0[3]); q.z = cvt_pk_bf16(v1[0], v1[1]); q.w = cvt_pk_bf16(v1[2], v1[3]);
                        *(u32x4*)(rowp + bj * HALF) = q; } } }
    }
};
struct EpiPle {
    static constexpr bool PERM = false;
    float* X; const bf16_t* X2; const bf16_t* PP; const float* rstd;
    __device__ __forceinline__ void operator()(const f32x4 (&acc)[2][2][4][2], const Unit& u, int wr, int wc, int fr, int fq) const {
        const int row0 = u.pm * BM + wr * 64 + fr, col0 = u.pn * BM + wc * 32 + 4 * fq;
#pragma unroll
        for (int ai = 0; ai < 2; ++ai)
#pragma unroll
            for (int m = 0; m < 4; ++m) { const int row = row0 + ai * HALF + m * 16; const size_t off = (size_t)row * DM + col0; const float rs = rstd[row];
#pragma unroll
                for (int bj = 0; bj < 2; ++bj)
#pragma unroll
                    for (int n = 0; n < 2; ++n) { const size_t o2 = off + bj * HALF + n * 16; const u32x2 xw = *(const u32x2*)(X2 + o2); const u32x2 pw = *(const u32x2*)(PP + o2); const f32x4 a = acc[ai][bj][m][n] * rs;
                        f32x4 r; r[0] = bf_lo(xw.x) + sigmoidf_(a[0]) * bf_lo(pw.x); r[1] = bf_hi(xw.x) + sigmoidf_(a[1]) * bf_hi(pw.x); r[2] = bf_lo(xw.y) + sigmoidf_(a[2]) * bf_lo(pw.y); r[3] = bf_hi(xw.y) + sigmoidf_(a[3]) * bf_hi(pw.y);
                        *(f32x4*)(X + o2) = r; } }
    }
};
}

namespace att {
typedef __attribute__((address_space(3))) const char* lds_cptr;
typedef short v4i16_t __attribute__((ext_vector_type(4)));
__device__ __forceinline__ int crow(int r, int hi) { return (r & 3) + 8 * (r >> 2) + 4 * hi; }
__device__ __forceinline__ void glds16(const void* gsrc, unsigned lds_dst) { unsigned keep;
    asm volatile("s_mov_b32 %0, m0\n\ts_mov_b32 m0, %2\n\ts_nop 0\n\tglobal_load_lds_dwordx4 %1, off\n\ts_mov_b32 m0, %0" : "=&s"(keep) : "v"(gsrc), "s"(lds_dst) : "memory"); }
__device__ __forceinline__ s16x4 vtr(lds_cptr p) { return __builtin_bit_cast(s16x4, __builtin_amdgcn_ds_read_tr16_b64_v4i16((__attribute__((address_space(3))) v4i16_t*)p)); }
__device__ __forceinline__ float swap_sum(float v) { auto rr = __builtin_amdgcn_permlane32_swap(__float_as_uint(v), __float_as_uint(v), false, false); return __uint_as_float(rr[0]) + __uint_as_float(rr[1]); }
__device__ __forceinline__ float swap_max(float v) { auto rr = __builtin_amdgcn_permlane32_swap(__float_as_uint(v), __float_as_uint(v), false, false); return fmaxf(__uint_as_float(rr[0]), __uint_as_float(rr[1])); }
#define ATT_MFMA(A, B, C) __builtin_amdgcn_mfma_f32_32x32x16_bf16((A), (B), (C), 0, 0, 0)
#define ATT_VFRAG(p) ({ const s16x4 _lo = vtr(p); const s16x4 _hi = vtr((p) + 512); (bf16x8){_lo[0], _lo[1], _lo[2], _lo[3], _hi[0], _hi[1], _hi[2], _hi[3]}; })

__device__ __forceinline__ void sb_unit(int b, int qi, int parity, const bf16_t* __restrict__ QKV, bf16_t* __restrict__ OB, char* shm) {
    const int lane = fresh_lane(), r32 = lane & 31, hi = lane >> 5; const int wid = fresh_wave();
    const long rowbase = (long)b * SEQ; const int t0 = qi * 32, h = wid;
    const bf16_t* Qp = QKV + (rowbase + t0 + r32) * NQKV + COL_QSB + h * 64 + hi * 8;
    bf16x8 qr[4];
#pragma unroll
    for (int d0 = 0; d0 < 4; ++d0) qr[d0] = *(const bf16x8*)(Qp + 16 * d0);
    const bf16_t* Kh = QKV + rowbase * NQKV + COL_KSB + h * 64;
    const bf16_t* Vh = QKV + rowbase * NQKV + COL_VSB + h * 64;
    char* vimg = shm + 8192 * wid;
    const lds_cptr vp0 = (lds_cptr)vimg + ((lane >> 4) & 1) * 32 + (lane & 3) * 8 + (4 * hi + ((lane & 15) >> 2)) * 64;
    f32x16 o0 = {}, o1 = {};
    float R = 0.f;
    const int jd = qi >> 1, tq = t0 + r32;
    for (int j = jd; j >= 0; --j) {
        const int kb = 64 * j;
        u32x4 vv[8];
#pragma unroll
        for (int it = 0; it < 8; ++it) vv[it] = *(const u32x4*)(Vh + (long)(kb + 8 * it + (lane >> 3)) * NQKV + (lane & 7) * 8);
        f32x16 p0 = {}, p1 = {};
#pragma unroll
        for (int d0 = 0; d0 < 4; ++d0) {
            const bf16x8 k0 = *(const bf16x8*)(Kh + (long)(kb + r32) * NQKV + 16 * d0 + 8 * hi);
            const bf16x8 k1 = *(const bf16x8*)(Kh + (long)(kb + 32 + r32) * NQKV + 16 * d0 + 8 * hi);
            p0 = ATT_MFMA(k0, qr[d0], p0); p1 = ATT_MFMA(k1, qr[d0], p1);
        }
#pragma unroll
        for (int it = 0; it < 8; ++it) *(u32x4*)(vimg + ((lane & 7) >> 2) * 4096 + (8 * it + (lane >> 3)) * 64 + (lane & 3) * 16) = vv[it];
        float lk[32], lb[32];
#pragma unroll
        for (int r = 0; r < 32; ++r) { const float z = (r < 16) ? p0[r & 15] : p1[r & 15];
            const float sp = fmaxf(z, 0.f) + fast_log2(1.0f + fast_exp2(-fabsf(z)));
            lk[r] = -sp; lb[r] = z - sp; }
        if (j == jd) {
#pragma unroll
            for (int r = 0; r < 32; ++r) { const int key = kb + crow(r & 15, hi) + (r >> 4) * 32; if (key >= tq) { lk[r] = 0.f; lb[r] = -INFINITY; } }
        }
        float lo[8], hv[8];
#pragma unroll
        for (int i = 0; i < 8; ++i) { const float gs = (lk[4 * i] + lk[4 * i + 1]) + (lk[4 * i + 2] + lk[4 * i + 3]);
            auto rr = __builtin_amdgcn_permlane32_swap(__float_as_uint(gs), __float_as_uint(gs), false, false); lo[i] = __uint_as_float(rr[0]); hv[i] = __uint_as_float(rr[1]); }
        float T = 0.f;
        float w[32];
#pragma unroll
        for (int i = 7; i >= 0; --i) {
            const float E = R + T + (hi == 0 ? hv[i] : 0.f);
            const float c3 = E, c2 = c3 + lk[4 * i + 3], c1 = c2 + lk[4 * i + 2], c0 = c1 + lk[4 * i + 1];
            w[4 * i + 3] = fast_exp2(lb[4 * i + 3] + c3); w[4 * i + 2] = fast_exp2(lb[4 * i + 2] + c2); w[4 * i + 1] = fast_exp2(lb[4 * i + 1] + c1); w[4 * i] = fast_exp2(lb[4 * i] + c0);
            T += lo[i] + hv[i];
        }
        R += T;
        u32x4 pw[4];
#pragma unroll
        for (int s = 0; s < 4; ++s) { pw[s].x = cvt_pk_bf16(w[8 * s], w[8 * s + 1]); pw[s].y = cvt_pk_bf16(w[8 * s + 2], w[8 * s + 3]); pw[s].z = cvt_pk_bf16(w[8 * s + 4], w[8 * s + 5]); pw[s].w = cvt_pk_bf16(w[8 * s + 6], w[8 * s + 7]); }
#pragma unroll
        for (int s = 0; s < 4; ++s) {
            const bf16x8 v0 = ATT_VFRAG(vp0 + s * 1024), v1 = ATT_VFRAG(vp0 + 4096 + s * 1024);
            o0 = ATT_MFMA(v0, __builtin_bit_cast(bf16x8, pw[s]), o0); o1 = ATT_MFMA(v1, __builtin_bit_cast(bf16x8, pw[s]), o1);
        }
        if (__all(R < -152.0f)) break;
    }
    float ss = 0.f;
#pragma unroll
    for (int r = 0; r < 16; ++r) ss += o0[r] * o0[r] + o1[r] * o1[r];
    ss = swap_sum(ss);
    float* red = (float*)(shm + 65536) + parity * 256;
    if (hi == 0) red[wid * 32 + r32] = ss;
    __syncthreads();
    float tot = 0.f;
#pragma unroll
    for (int w8 = 0; w8 < 8; ++w8) tot += red[w8 * 32 + r32];
    const float rstd = 1.0f / sqrtf(tot * (1.0f / 512.0f) + EPS);
    bf16_t* Op = OB + (rowbase + t0 + r32) * DM + h * 64 + 4 * hi;
#pragma unroll
    for (int i = 0; i < 4; ++i) {
        u32x2 a; a.x = cvt_pk_bf16(o0[4 * i] * rstd, o0[4 * i + 1] * rstd); a.y = cvt_pk_bf16(o0[4 * i + 2] * rstd, o0[4 * i + 3] * rstd); *(u32x2*)(Op + 8 * i) = a;
        u32x2 c; c.x = cvt_pk_bf16(o1[4 * i] * rstd, o1[4 * i + 1] * rstd); c.y = cvt_pk_bf16(o1[4 * i + 2] * rstd, o1[4 * i + 3] * rstd); *(u32x2*)(Op + 32 + 8 * i) = c;
    }
}

constexpr int DF_KSLOT = 16384, DF_VBASE = 49152, DF_THR = 8;
__device__ __forceinline__ float max3f(float a, float b, float c) { return __builtin_fmaxf(__builtin_fmaxf(a, b), c); }
__device__ __forceinline__ void df_unit(int b, int h, int qb, const bf16_t* __restrict__ QKV, bf16_t* __restrict__ OB, char* shm, float lam, float slope2) {
    const int lane = fresh_lane(), r32 = lane & 31, hi = lane >> 5; const int wid = fresh_wave();
    const int c = wid & 1, qs = wid >> 1;
    const bool orderA = wid < 4;
    const long rowbase = (long)b * SEQ; const int t0 = qb * 128, tq0 = t0 + 32 * qs, NT = 2 * qb + 2, jdw = 2 * qb + (qs >> 1);
    const bf16_t* Kg = QKV + rowbase * NQKV + COL_KDF + h * 128;
    const bf16_t* Vg = QKV + rowbase * NQKV + COL_VDF + h * 128;
    const unsigned lds0 = (unsigned)(uintptr_t)shm;
    const bf16_t* ksrc0 = Kg + (long)lane * NQKV + wid * 8;
    const bf16_t* vsrc0 = Vg + (long)(16 * (wid & 3) + (lane >> 2)) * NQKV + (wid >> 2) * 32 + (lane & 3) * 8;
#define DF_DMA_K(j, slot) do { const long _ro = (long)(j) * 64 * NQKV; const unsigned _d = (unsigned)__builtin_amdgcn_readfirstlane(lds0 + (slot) * DF_KSLOT + wid * 1024); \
        glds16(ksrc0 + _ro, _d); glds16(ksrc0 + 64 + _ro, _d + 8192); } while (0)
#define DF_DMA_V(j, slot) do { const long _ro = (long)(j) * 64 * NQKV; const unsigned _d = (unsigned)__builtin_amdgcn_readfirstlane(lds0 + DF_VBASE + (slot) * DF_KSLOT + wid * 1024); \
        glds16(vsrc0 + _ro, _d); glds16(vsrc0 + 64 + _ro, _d + 8192); } while (0)
    DF_DMA_K(NT - 1, 0); DF_DMA_K(NT - 2, 1); DF_DMA_V(NT - 1, 0);
    const bf16_t* Qp = QKV + (rowbase + tq0 + r32) * NQKV + COL_QDF + h * 128 + c * 64 + hi * 8;
    bf16x8 qr[4];
#pragma unroll
    for (int d0 = 0; d0 < 4; ++d0) qr[d0] = *(const bf16x8*)(Qp + 16 * d0);
    __builtin_amdgcn_s_waitcnt(0);
#pragma unroll
    for (int d0 = 0; d0 < 4; ++d0) asm volatile("" : "+v"(qr[d0]));
    f32x16 o[4]; o[0] = f32x16{}; o[1] = f32x16{}; o[2] = f32x16{}; o[3] = f32x16{};
    float mhat = 0.f, l = 0.f;
    const lds_cptr shm3 = (lds_cptr)shm;
    const int koff = (8 * c + hi) * 1024 + r32 * 16;
    const int voff = DF_VBASE + ((lane >> 4) & 1) * 32 + (lane & 3) * 8 + (4 * hi + ((lane & 15) >> 2)) * 64;
    const int tq = tq0 + r32;
    u32x4 q0[4], q1[4];
#pragma unroll
    for (int s = 0; s < 4; ++s) { q0[s] = (u32x4){0u, 0u, 0u, 0u}; q1[s] = (u32x4){0u, 0u, 0u, 0u}; }
    int kslot = 0;
    int issued_prev = 4;
    bool resc = false; float fres = 1.0f;
#define DF_BAR(k) do { \
        if (issued_prev == 4) asm volatile("s_waitcnt vmcnt(4) lgkmcnt(0)\n\ts_barrier" ::: "memory"); \
        else if (issued_prev == 2) asm volatile("s_waitcnt vmcnt(2) lgkmcnt(0)\n\ts_barrier" ::: "memory"); \
        else asm volatile("s_waitcnt vmcnt(0) lgkmcnt(0)\n\ts_barrier" ::: "memory"); \
        issued_prev = 0; \
        if ((k) + 2 < NT) { const int s2 = (kslot == 0) ? 2 : kslot - 1; DF_DMA_K(NT - 3 - (k), s2); issued_prev += 2; }                   \
        if ((k) + 1 < NT) { const int v2 = (kslot == 2) ? 0 : kslot + 1; DF_DMA_V(NT - 2 - (k), v2); issued_prev += 2; }                   \
    } while (0)
    for (int k = 0; k <= NT + 1; ++k) {
        if (!orderA) { DF_BAR(k); if (resc) {
#pragma unroll
            for (int d = 0; d < 4; ++d)
#pragma unroll
                for (int r = 0; r < 16; ++r) o[d][r] *= fres;
            resc = false; } }
        {
            const int x = orderA ? k - 2 : k - 1;
            if (x >= 0 && x < NT && (NT - 1 - x) <= jdw) {
                const int vs = orderA ? ((kslot == 0) ? 1 : (kslot == 1) ? 2 : 0) : ((kslot == 0) ? 2 : kslot - 1);
                const lds_cptr vp = shm3 + vs * DF_KSLOT + voff;
                u32x4 ps[4];
#pragma unroll
                for (int s = 0; s < 4; ++s) ps[s] = orderA ? q0[s] : q1[s];
#pragma unroll
                for (int s = 0; s < 4; ++s)
#pragma unroll
                    for (int d = 0; d < 4; ++d) { const bf16x8 vf = ATT_VFRAG(vp + d * 4096 + s * 1024); o[d] = ATT_MFMA(vf, __builtin_bit_cast(bf16x8, ps[s]), o[d]); }
            }
        }
        if (orderA) { if (resc) {
#pragma unroll
            for (int d = 0; d < 4; ++d)
#pragma unroll
                for (int r = 0; r < 16; ++r) o[d][r] *= fres;
            resc = false; }
            DF_BAR(k); }
        const int j = NT - 1 - k;
#pragma unroll
        for (int s = 0; s < 4; ++s) q0[s] = q1[s];
        if (k < NT && j <= jdw) {
            const lds_cptr kp = shm3 + kslot * DF_KSLOT + koff; const int kb = 64 * j; const bool diag = (j == jdw);
            float s2v = slope2; asm volatile("" : "+v"(s2v));
            const float basev = s2v * (float)(kb - tq0 + 4 * hi) - mhat;
            f32x16 p0, p1;
#pragma unroll
            for (int r = 0; r < 16; ++r) { p0[r] = fmaf(s2v, (float)((r & 3) + 8 * (r >> 2)), basev); p1[r] = fmaf(s2v, (float)(32 + (r & 3) + 8 * (r >> 2)), basev); }
#pragma unroll
            for (int d0 = 0; d0 < 4; ++d0) {
                const bf16x8 k0 = *(const __attribute__((address_space(3))) bf16x8*)(kp + d0 * 2048);
                const bf16x8 k1 = *(const __attribute__((address_space(3))) bf16x8*)(kp + d0 * 2048 + 512);
                p0 = ATT_MFMA(k0, qr[d0], p0); p1 = ATT_MFMA(k1, qr[d0], p1); }
            if (diag) {
#pragma unroll
                for (int r = 0; r < 16; ++r) { const int key = kb + crow(r, hi); if (key > tq) p0[r] = -INFINITY; if (key + 32 > tq) p1[r] = -INFINITY; } }
            float rm = max3f(p0[0], p0[1], p1[0]); rm = max3f(rm, p1[1], p0[2]);
#pragma unroll
            for (int r = 3; r < 16; ++r) rm = max3f(rm, p0[r], p1[r - 1]);
            rm = fmaxf(rm, p1[15]); rm = swap_max(rm);
            if (diag) { mhat = rm;
#pragma unroll
                for (int r = 0; r < 16; ++r) { p0[r] -= rm; p1[r] -= rm; } }
            else if (__any(rm > (float)DF_THR)) { const float dl = fmaxf(rm, 0.f); mhat += dl;
#pragma unroll
                for (int r = 0; r < 16; ++r) { p0[r] -= dl; p1[r] -= dl; }
                fres = fast_exp2(-dl); l *= fres; resc = true; }
            float sacc = 0.f;
#pragma unroll
            for (int r = 0; r < 16; ++r) { p0[r] = fast_exp2(p0[r]); p1[r] = fast_exp2(p1[r]); sacc += p0[r] + p1[r]; }
            l += sacc;
#pragma unroll
            for (int s = 0; s < 2; ++s) {
                q1[s].x = cvt_pk_bf16(p0[8 * s], p0[8 * s + 1]); q1[s].y = cvt_pk_bf16(p0[8 * s + 2], p0[8 * s + 3]); q1[s].z = cvt_pk_bf16(p0[8 * s + 4], p0[8 * s + 5]); q1[s].w = cvt_pk_bf16(p0[8 * s + 6], p0[8 * s + 7]);
                q1[2 + s].x = cvt_pk_bf16(p1[8 * s], p1[8 * s + 1]); q1[2 + s].y = cvt_pk_bf16(p1[8 * s + 2], p1[8 * s + 3]); q1[2 + s].z = cvt_pk_bf16(p1[8 * s + 4], p1[8 * s + 5]); q1[2 + s].w = cvt_pk_bf16(p1[8 * s + 6], p1[8 * s + 7]); }
        }
        kslot = (kslot == 2) ? 0 : kslot + 1;
    }
    if (resc) {
#pragma unroll
        for (int d = 0; d < 4; ++d)
#pragma unroll
            for (int r = 0; r < 16; ++r) o[d][r] *= fres; }
#undef DF_BAR
#undef DF_DMA_K
#undef DF_DMA_V
    asm volatile("s_waitcnt vmcnt(0) lgkmcnt(0)\n\ts_barrier" ::: "memory");
    l = swap_sum(l);
    const float inv = 1.0f / l;
    float* xch = (float*)shm + qs * 4096;
    if (c == 1) {
        const float sc = inv * lam;
#pragma unroll
        for (int d = 0; d < 4; ++d)
#pragma unroll
            for (int r = 0; r < 16; ++r) xch[(d * 16 + r) * 64 + lane] = o[d][r] * sc;
    }
    __syncthreads();
    if (c == 0) {
        float ss = 0.f;
#pragma unroll
        for (int d = 0; d < 4; ++d)
#pragma unroll
            for (int r = 0; r < 16; ++r) { const float v = o[d][r] * inv - xch[(d * 16 + r) * 64 + lane]; o[d][r] = v; ss += v * v; }
        ss = swap_sum(ss);
        const float rstd = 1.0f / sqrtf(ss * (1.0f / 128.0f) + EPS);
        bf16_t* Op = OB + (rowbase + tq0 + r32) * DM + 512 + h * 128 + 4 * hi;
#pragma unroll
        for (int d = 0; d < 4; ++d)
#pragma unroll
            for (int i = 0; i < 4; ++i) { u32x2 a; a.x = cvt_pk_bf16(o[d][4 * i] * rstd, o[d][4 * i + 1] * rstd); a.y = cvt_pk_bf16(o[d][4 * i + 2] * rstd, o[d][4 * i + 3] * rstd); *(u32x2*)(Op + d * 32 + 8 * i) = a; }
    }
    __syncthreads();
}
}

#define XB_TMO      128
#define XB_XCNT(j)  (256  + 64 * (j))
#define XB_XSUB(j)  (1280 + 64 * (j))
#define XB_XGEN(j)  (2304 + 64 * (j))
#define XB_TOP      3328
#define XB_TOPGEN   3392
#define XCD_BAR_WORDS 3456
#define XB_SPIN_CAP (1u << 18)
__device__ __forceinline__ unsigned xb_ld(unsigned* p)              { return __hip_atomic_load(p, __ATOMIC_RELAXED, __HIP_MEMORY_SCOPE_AGENT); }
__device__ __forceinline__ unsigned xb_add(unsigned* p, unsigned v) { return __hip_atomic_fetch_add(p, v, __ATOMIC_RELAXED, __HIP_MEMORY_SCOPE_AGENT); }
__device__ __forceinline__ unsigned xb_xcc_id() { return (unsigned)__builtin_amdgcn_s_getreg((3 << 11) | 20) & 0xFu; }
#define XB_SPIN(cond, bar) do { unsigned _sp = 0; while (cond) { __builtin_amdgcn_s_sleep(1); \
    if ((++_sp & 255u) == 0u) { if (xb_ld(&(bar)[XB_TMO])) break; if (_sp > XB_SPIN_CAP) { atomicAdd(&(bar)[XB_TMO], 1u); break; } } } } while (0)
struct XcdBarrier { unsigned* bar; unsigned x; volatile LAS unsigned* st; };
__device__ __forceinline__ XcdBarrier xcd_barrier_post(unsigned* bar, volatile LAS unsigned* st) {
    XcdBarrier b; b.bar = bar; b.x = xb_xcc_id(); b.st = st;
    if (threadIdx.x == 0) (void)xb_add(&bar[XB_XCNT(b.x)], 1u);
    return b;
}
__device__ __forceinline__ void xcd_barrier_complete(unsigned* bar, unsigned x, unsigned& nloc, unsigned& nx) {
    const unsigned G = gridDim.x * gridDim.y * gridDim.z;
    unsigned sum, cnt, mine, sp = 0u;
    for (;;) {
        sum = 0u; cnt = 0u; mine = 0u;
#pragma unroll
        for (unsigned j = 0; j < 16; ++j) { const unsigned c = xb_ld(&bar[XB_XCNT(j)]); sum += c; cnt += (c > 0u) ? 1u : 0u; mine = (j == x) ? c : mine; }
        if (sum == G) break;
        __builtin_amdgcn_s_sleep(1);
        if ((++sp & 255u) == 0u) { if (xb_ld(&bar[XB_TMO])) break; if (sp > XB_SPIN_CAP) { atomicAdd(&bar[XB_TMO], 1u); break; } }
    }
    nloc = mine > 0u ? mine : 1u; nx = cnt > 0u ? cnt : 1u;
}
__device__ __forceinline__ void xcd_barrier(const XcdBarrier& b) {
    asm volatile("s_waitcnt vmcnt(0)" ::: "memory");
    __syncthreads();
    if (threadIdx.x == 0) {
        unsigned* bar = b.bar;
        __builtin_amdgcn_s_waitcnt(0);
        unsigned nloc = b.st[0], nx = b.st[1];
        if (nloc == 0u) { xcd_barrier_complete(bar, b.x, nloc, nx); b.st[0] = nloc; b.st[1] = nx; }
        const unsigned old = xb_add(&bar[XB_XSUB(b.x)], 1u);
        const unsigned gen = old / nloc;
        if (old + 1u == (gen + 1u) * nloc) {
            __builtin_amdgcn_fence(__ATOMIC_RELEASE, "agent");
            asm volatile("s_waitcnt vmcnt(0)" ::: "memory");
            const unsigned og = xb_add(&bar[XB_TOP], 1u);
            const unsigned tg = og / nx;
            if (og + 1u == (tg + 1u) * nx) xb_add(&bar[XB_TOPGEN], 1u);
            else XB_SPIN(xb_ld(&bar[XB_TOPGEN]) == tg, bar);
            __builtin_amdgcn_fence(__ATOMIC_ACQUIRE, "agent");
            xb_add(&bar[XB_XGEN(b.x)], 1u);
            asm volatile("s_waitcnt vmcnt(0)" ::: "memory");
        } else {
            XB_SPIN(xb_ld(&bar[XB_XGEN(b.x)]) == gen, bar);
            __builtin_amdgcn_fence(__ATOMIC_ACQUIRE, "agent");
            asm volatile("s_waitcnt vmcnt(0)" ::: "memory");
        }
    }
    __syncthreads();
}

__device__ __forceinline__ unsigned pk2(float lo, float hi) { return cvt_pk_bf16(lo, hi); }
__device__ __forceinline__ void p0_transpose_item(const float* __restrict__ W, int K, int N, bf16_t* __restrict__ WT, int kb, int nb, int wtrow, LAS float* scr, int lane, int mode, const float* __restrict__ g0, const float* __restrict__ g1) {
    const int k0 = 64 * kb, n0 = 32 * nb;
#pragma unroll 8
    for (int i = 0; i < 32; ++i) { const int kk = 2 * i + (lane >> 5); float v = W[(size_t)(k0 + kk) * N + n0 + (lane & 31)];
        if (mode == 1) { const int k = k0 + kk; v *= (k < 512) ? g0[k] : g1[(k - 512) & 127] * (1.0f - LAMBDA_INIT); }
        else if (mode == 2) { v *= g0[k0 + kk]; }
        scr[kk * 33 + (lane & 31)] = v; }
    LDS_WAIT(); asm volatile("" ::: "memory");
    const int c = lane & 7;
#pragma unroll
    for (int j = 0; j < 4; ++j) { const int n = (lane >> 3) + 8 * j; const LAS float* s = scr + (8 * c) * 33 + n;
        u32x4 o; o.x = pk2(s[0 * 33], s[1 * 33]); o.y = pk2(s[2 * 33], s[3 * 33]); o.z = pk2(s[4 * 33], s[5 * 33]); o.w = pk2(s[6 * 33], s[7 * 33]);
        *(u32x4*)(WT + (size_t)(wtrow + n) * K + k0 + 8 * c) = o; }
    LDS_WAIT(); asm volatile("" ::: "memory");
}

struct Ptrs {
    float* out; unsigned char* ws;
#define PIN(name, idx) __device__ __forceinline__ const float* name() const { const float* p; auto ka = __builtin_amdgcn_kernarg_segment_ptr(); asm volatile("s_load_dwordx2 %0, %1, " #idx "*8\n\ts_waitcnt lgkmcnt(0)" : "=s"(p) : "s"(ka)); return p; }
    PIN(x, 0) PIN(p, 1) PIN(g_mix, 2) PIN(w_in, 3) PIN(lq1, 4) PIN(lk1, 5) PIN(lq2, 6) PIN(lk2, 7) PIN(g_sb, 8) PIN(g_df, 9) PIN(w_out, 10) PIN(g_ffn, 11) PIN(w_rg, 12) PIN(b_rg, 13) PIN(w_re, 14) PIN(b_re, 15)
    PIN(w_eg, 16) PIN(w_eu, 17) PIN(w_ed, 18) PIN(g_ple, 19) PIN(w_pg, 20) PIN(w_pp, 21) PIN(g_final, 22)
#undef PIN
};

__device__ __forceinline__ void p0_prologue(const Ptrs& P, LAS unsigned char* lds, int gw, int NGW, int lane, int wave) {
    LAS float* scr = (LAS float*)(lds + wave * 16384);
    bf16_t* Win_t = (bf16_t*)(P.ws + WS_WIN); bf16_t* Wout_t = (bf16_t*)(P.ws + WS_WOUT); bf16_t* Wgu_t = (bf16_t*)(P.ws + WS_WGU); bf16_t* Wd_t = (bf16_t*)(P.ws + WS_WD);
    bf16_t* Wpg_t = (bf16_t*)(P.ws + WS_WPG); bf16_t* Wpp_t = (bf16_t*)(P.ws + WS_WPP);
    constexpr int I_IN = 16 * 96, I_OUT = 16 * 32, I_EG = NEXP * 16 * 16, I_ED = NEXP * 8 * 32, I_PG = 16 * 32, I_PP = 4 * 32;
    constexpr int NITEMS = I_IN + I_OUT + 2 * I_EG + I_ED + I_PG + I_PP;
    const float *w_in = P.w_in(), *w_out = P.w_out(), *g_sb = P.g_sb(), *g_df = P.g_df(), *w_eg = P.w_eg(), *w_eu = P.w_eu(), *w_ed = P.w_ed(), *w_pg = P.w_pg(), *g_ple = P.g_ple(), *w_pp = P.w_pp(), *g_ffn = P.g_ffn();
    for (int it = gw; it < NITEMS; it += NGW) {
        int r = it;
        if (r < I_IN) { const int kb = r / 96, nb = r % 96; p0_transpose_item(w_in, 1024, 3072, Win_t, kb, nb, 32 * nb, scr, lane, 0, nullptr, nullptr); continue; } r -= I_IN;
        if (r < I_OUT) { const int kb = r / 32, nb = r % 32; p0_transpose_item(w_out, 1024, 1024, Wout_t, kb, nb, 32 * nb, scr, lane, 1, g_sb, g_df); continue; } r -= I_OUT;
        if (r < 2 * I_EG) { const int up = r / I_EG; r -= up * I_EG; const int e = r / 256, q = r % 256, kb = q / 16, nb = q % 16; const int n0 = 32 * nb;
            p0_transpose_item((up ? w_eu : w_eg) + (size_t)e * 1024 * 512, 1024, 512, Wgu_t, kb, nb, e * 1024 + (n0 >> 7) * 256 + up * 128 + (n0 & 127), scr, lane, 2, g_ffn, nullptr); continue; } r -= 2 * I_EG;
        if (r < I_ED) { const int e = r / 256, q = r % 256, kb = q / 32, nb = q % 32; p0_transpose_item(w_ed + (size_t)e * 512 * 1024, 512, 1024, Wd_t, kb, nb, e * 1024 + 32 * nb, scr, lane, 0, nullptr, nullptr); continue; } r -= I_ED;
        if (r < I_PG) { const int kb = r / 32, nb = r % 32; p0_transpose_item(w_pg, 1024, 1024, Wpg_t, kb, nb, 32 * nb, scr, lane, 2, g_ple, nullptr); continue; } r -= I_PG;
        { const int kb = r / 32, nb = r % 32; p0_transpose_item(w_pp, 256, 1024, Wpp_t, kb, nb, 32 * nb, scr, lane, 0, nullptr, nullptr); }
    }
    bf16_t* XN = (bf16_t*)(P.ws + WS_XN); bf16_t* PB = (bf16_t*)(P.ws + WS_PB);
    f32x4 gm[4];
#pragma unroll
    for (int j = 0; j < 4; ++j) gm[j] = *((const f32x4*)P.g_mix() + lane + 64 * j);
    const float* xin = P.x(); const float* pin = P.p();
    for (int m = gw; m < NTOK; m += NGW) {
        const f32x4* xr = (const f32x4*)(xin + (size_t)m * DM) + lane;
        f32x4 v[4]; float s = 0.f;
#pragma unroll
        for (int j = 0; j < 4; ++j) { v[j] = xr[64 * j]; s += (v[j].x * v[j].x + v[j].y * v[j].y) + (v[j].z * v[j].z + v[j].w * v[j].w); }
        const float rstd = 1.0f / sqrtf(wave_sum(s) * (1.0f / DM) + EPS);
        unsigned long long* o8 = (unsigned long long*)(XN + (size_t)m * DM) + lane;
#pragma unroll
        for (int j = 0; j < 4; ++j) { const f32x4 y = v[j] * rstd * gm[j]; o8[64 * j] = (unsigned long long)pk2(y.x, y.y) | ((unsigned long long)pk2(y.z, y.w) << 32); }
        const f32x4 pv = *((const f32x4*)(pin + (size_t)m * PLE) + lane);
        *((unsigned long long*)(PB + (size_t)m * PLE) + lane) = (unsigned long long)pk2(pv.x, pv.y) | ((unsigned long long)pk2(pv.z, pv.w) << 32);
    }
}

__device__ __forceinline__ void p4_router(const Ptrs& P, LAS unsigned char* lds, unsigned* ctl, int vb, int nblk, int tid, int lane, int wave) {
    LAS float* WrT = (LAS float*)lds;
    LAS int* st_e = (LAS int*)(lds + 81920); LAS int* st_pos = st_e + 256; LAS int* st_tok = st_pos + 256; LAS float* st_w = (LAS float*)(st_tok + 256);
    LAS unsigned* lcnt = (LAS unsigned*)(st_w + 256); LAS unsigned* lbase = lcnt + 16;
    const float *w_rg = P.w_rg(), *w_re = P.w_re(), *g_ffn = P.g_ffn(), *b_rg = P.b_rg(), *b_re = P.b_re();
    {
        float t[8];
#pragma unroll
        for (int bb = 0; bb < 4; ++bb) {
#pragma unroll
            for (int u = 0; u < 8; ++u) { const int i = tid + 512 * (bb * 8 + u); t[u] = w_re[i] * g_ffn[i >> 4]; }
#pragma unroll
            for (int u = 0; u < 8; ++u) { const int i = tid + 512 * (bb * 8 + u); WrT[(4 + (i & 15)) * 1024 + (i >> 4)] = t[u]; }
        }
#pragma unroll
        for (int u = 0; u < 8; ++u) { const int i = tid + 512 * u; t[u] = w_rg[i] * g_ffn[i >> 2]; }
#pragma unroll
        for (int u = 0; u < 8; ++u) { const int i = tid + 512 * u; WrT[(i & 3) * 1024 + (i >> 2)] = t[u]; }
    }
    const bf16_t* X1B = (const bf16_t*)(P.ws + WS_XN); int* list = (int*)(P.ws + WS_LIST); float* rstd2 = (float*)(P.ws + WS_RSTD2);
    float bg[4], be[16];
#pragma unroll
    for (int i = 0; i < 4; ++i) bg[i] = b_rg[i];
#pragma unroll
    for (int i = 0; i < 16; ++i) be[i] = b_re[i];
    for (int blk = vb; blk < NTOK / 128; blk += nblk) {
        if (tid < 16) lcnt[tid] = 0u;
        __syncthreads();
        u32x2 na[4], nb[4];
        { const int m0 = blk * 128 + wave * 16;
#pragma unroll
          for (int j = 0; j < 4; ++j) { na[j] = *((const u32x2*)(X1B + (size_t)m0 * DM) + lane + 64 * j); nb[j] = *((const u32x2*)(X1B + (size_t)(m0 + 1) * DM) + lane + 64 * j); } }
        for (int rp = 0; rp < 8; ++rp) {
            const int m0 = blk * 128 + wave * 16 + rp * 2;
            f32x4 va[4], vb4[4]; float sa = 0.f, sb = 0.f;
#pragma unroll
            for (int j = 0; j < 4; ++j) { va[j] = (f32x4){bf_lo(na[j].x), bf_hi(na[j].x), bf_lo(na[j].y), bf_hi(na[j].y)}; vb4[j] = (f32x4){bf_lo(nb[j].x), bf_hi(nb[j].x), bf_lo(nb[j].y), bf_hi(nb[j].y)}; }
            if (rp < 7) {
#pragma unroll
                for (int j = 0; j < 4; ++j) { na[j] = *((const u32x2*)(X1B + (size_t)(m0 + 2) * DM) + lane + 64 * j); nb[j] = *((const u32x2*)(X1B + (size_t)(m0 + 3) * DM) + lane + 64 * j); } }
#pragma unroll
            for (int j = 0; j < 4; ++j) {
                sa += (va[j].x * va[j].x + va[j].y * va[j].y) + (va[j].z * va[j].z + va[j].w * va[j].w); sb += (vb4[j].x * vb4[j].x + vb4[j].y * vb4[j].y) + (vb4[j].z * vb4[j].z + vb4[j].w * vb4[j].w); }
            const float ra = 1.0f / sqrtf(wave_sum(sa) * (1.0f / DM) + EPS), rb = 1.0f / sqrtf(wave_sum(sb) * (1.0f / DM) + EPS);
            if (lane == 0) { rstd2[m0] = ra; rstd2[m0 + 1] = rb; }
            float la[20], lb[20];
#pragma unroll
            for (int c = 0; c < 20; ++c) { float a = 0.f, b = 0.f;
#pragma unroll
                for (int j = 0; j < 4; ++j) { const f32x4 w = *((const LAS f32x4*)(WrT + c * 1024) + lane + 64 * j);
                    a += (va[j].x * w.x + va[j].y * w.y) + (va[j].z * w.z + va[j].w * w.w); b += (vb4[j].x * w.x + vb4[j].y * w.y) + (vb4[j].z * w.z + vb4[j].w * w.w); }
                la[c] = wave_sum(a) * ra; lb[c] = wave_sum(b) * rb; }
            float lg[20];
#pragma unroll
            for (int c = 0; c < 20; ++c) lg[c] = (lane == 1 ? lb[c] : la[c]) + (c < 4 ? bg[c] : be[c - 4]);
            int gi = 0; float gmax = lg[0];
#pragma unroll
            for (int i = 1; i < 4; ++i) if (lg[i] > gmax) { gmax = lg[i]; gi = i; }
            float gsum = 0.f;
#pragma unroll
            for (int i = 0; i < 4; ++i) gsum += __expf(lg[i] - gmax);
            const float gwt = 1.0f / gsum;
            float ig[4];
#pragma unroll
            for (int i = 0; i < 4; ++i) ig[i] = gi == 0 ? lg[4 + i] : gi == 1 ? lg[8 + i] : gi == 2 ? lg[12 + i] : lg[16 + i];
            int i0 = 0; float v0 = ig[0];
#pragma unroll
            for (int i = 1; i < 4; ++i) if (ig[i] > v0) { v0 = ig[i]; i0 = i; }
            int i1 = -1; float v1 = -INFINITY;
#pragma unroll
            for (int i = 0; i < 4; ++i) if (i != i0 && (i1 < 0 || ig[i] > v1)) { v1 = ig[i]; i1 = i; }
            const float w0 = 1.0f / (1.0f + __expf(v1 - v0)), w1 = 1.0f - w0;
            if (lane < 2) {
                const int m = m0 + lane, e0 = gi * 4 + i0, e1 = gi * 4 + i1, si = 2 * (wave * 16 + rp * 2 + lane);
                st_e[si] = e0; st_pos[si] = (int)atomicAdd((unsigned*)&lcnt[e0], 1u); st_tok[si] = 2 * m; st_w[si] = w0 * gwt;
                st_e[si + 1] = e1; st_pos[si + 1] = (int)atomicAdd((unsigned*)&lcnt[e1], 1u); st_tok[si + 1] = 2 * m + 1; st_w[si + 1] = w1 * gwt;
            }
        }
        __syncthreads();
        if (tid < 16) lbase[tid] = lcnt[tid] ? __hip_atomic_fetch_add(ctl + CW_CNT + 64 * tid, lcnt[tid], RLX_AGENT) : 0u;
        __syncthreads();
        if (tid < 256) { const int e = st_e[tid]; const size_t slot = (size_t)e * LIST_CAP + lbase[e] + st_pos[tid]; int2 ent; ent.x = st_tok[tid]; ent.y = __float_as_int(st_w[tid]); *(int2*)(list + 2 * slot) = ent; }
        __syncthreads();
    }
}

__device__ __forceinline__ void p7_rows(const Ptrs& P, int gw, int NGW, int lane) {
    const bf16_t* X1B = (const bf16_t*)(P.ws + WS_XN); bf16_t* X2B = (bf16_t*)(P.ws + WS_X2B); const bf16_t* YB = (const bf16_t*)(P.ws + WS_YB); float* rstd3 = (float*)(P.ws + WS_RSTD3);
    for (int m = gw; m < NTOK; m += NGW) {
        const u32x2* xr = (const u32x2*)(X1B + (size_t)m * DM) + lane;
        const u32x2* y0 = (const u32x2*)(YB + (size_t)(2 * m) * DM) + lane; const u32x2* y1 = (const u32x2*)(YB + (size_t)(2 * m + 1) * DM) + lane;
        f32x4 v[4]; float s = 0.f;
#pragma unroll
        for (int j = 0; j < 4; ++j) { const u32x2 x = xr[64 * j], a = y0[64 * j], b = y1[64 * j];
            v[j].x = bf_lo(x.x) + bf_lo(a.x) + bf_lo(b.x); v[j].y = bf_hi(x.x) + bf_hi(a.x) + bf_hi(b.x); v[j].z = bf_lo(x.y) + bf_lo(a.y) + bf_lo(b.y); v[j].w = bf_hi(x.y) + bf_hi(a.y) + bf_hi(b.y); }
        u32x2 ow[4];
#pragma unroll
        for (int j = 0; j < 4; ++j) { ow[j].x = pk2(v[j].x, v[j].y); ow[j].y = pk2(v[j].z, v[j].w);
            const float a0 = bf_lo(ow[j].x), a1 = bf_hi(ow[j].x), a2 = bf_lo(ow[j].y), a3 = bf_hi(ow[j].y);
            s += (a0 * a0 + a1 * a1) + (a2 * a2 + a3 * a3); }
        const float rstd = 1.0f / sqrtf(wave_sum(s) * (1.0f / DM) + EPS);
        u32x2* o8 = (u32x2*)(X2B + (size_t)m * DM) + lane;
#pragma unroll
        for (int j = 0; j < 4; ++j) o8[64 * j] = ow[j];
        if (lane == 0) rstd3[m] = rstd;
    }
}
__device__ __forceinline__ void p10_rows(const Ptrs& P, int gw, int NGW, int lane) {
    f32x4 gf[4];
#pragma unroll
    for (int j = 0; j < 4; ++j) gf[j] = *((const f32x4*)P.g_final() + lane + 64 * j);
    for (int m = gw; m < NTOK; m += NGW) {
        f32x4* xr = (f32x4*)(P.out + (size_t)m * DM) + lane;
        f32x4 v[4]; float s = 0.f;
#pragma unroll
        for (int j = 0; j < 4; ++j) { v[j] = xr[64 * j]; s += (v[j].x * v[j].x + v[j].y * v[j].y) + (v[j].z * v[j].z + v[j].w * v[j].w); }
        const float rstd = 1.0f / sqrtf(wave_sum(s) * (1.0f / DM) + EPS);
#pragma unroll
        for (int j = 0; j < 4; ++j) xr[64 * j] = v[j] * rstd * gf[j];
    }
}

enum { PH_PROLOGUE = 0, PH_INPROJ, PH_ATT_SB, PH_ATT_DF, PH_OUTPROJ, PH_ROUTER, PH_GATEUP, PH_DOWN, PH_ROWS_X2, PH_PLE_PROJ, PH_PLE_GATE, PH_FINAL, PH_COUNT };
struct Args { const float* in[23]; float* out; unsigned char* ws; int ph_lo, ph_hi; };
static_assert(sizeof(Args) == 23 * 8 + 16 + 8, "Args has no padding holes");
__global__ void __launch_bounds__(NWAVES * 64, 2) hymba_fwd(Args args) {
    extern __shared__ __attribute__((aligned(16))) unsigned char lds_raw[];
    LAS unsigned char* lds = (LAS unsigned char*)lds_raw;
    volatile LAS unsigned* MISC = (volatile LAS unsigned*)(lds + MISC_OFF);
    const int wave = fresh_wave();
    const int G = gridDim.x; const int bx = blockIdx.x; const int vcu = (G % 8 == 0) ? (bx % 8) * (G / 8) + bx / 8 : bx;
    Ptrs P; P.out = args.out; P.ws = args.ws;
    unsigned* ctl = (unsigned*)(args.ws + WS_CTL);
    for (int u = threadIdx.x; u < (LDS_BYTES - LDSCTL_OFF) / 4; u += NWAVES * 64) ((LAS unsigned*)(lds + LDSCTL_OFF))[u] = 0u;
    __syncthreads();
    const int lo = args.ph_lo, hi = args.ph_hi;
    XcdBarrier bar; bar.bar = ctl + CW_BAR; bar.x = 0; bar.st = nullptr;
    if (hi - lo > 1) bar = xcd_barrier_post(ctl + CW_BAR, MISC + 8);
#define IN(k) (lo <= (k) && (k) < hi)
#define SEAM(k) do { if (IN(k) && IN((k) + 1)) xcd_barrier(bar); } while (0)
    const int gw = vcu * NWAVES + wave, NGW = G * NWAVES;
    bf16_t* XN = (bf16_t*)(args.ws + WS_XN); bf16_t* QKV = (bf16_t*)(args.ws + WS_QKV); bf16_t* OB = (bf16_t*)(args.ws + WS_OB);

    if (IN(PH_PROLOGUE)) { p0_prologue(P, lds, gw, NGW, fresh_lane(), wave); }
    SEAM(PH_PROLOGUE);
    if (IN(PH_INPROJ)) {
        pg8::Gemm g{XN, (const bf16_t*)(args.ws + WS_WIN), 1024, nullptr, 0}; pg8::StaticOrder S; S.init(NTOK, NQKV, G, bx);
        pg8::EpiQKV E{QKV};
        pg8::gemm_phase<pg8::EpiQKV, pg8::StaticOrder, false>(lds, g, S, E);
    }
    SEAM(PH_INPROJ);
    if (IN(PH_ATT_SB)) {
        char* shm = (char*)lds_raw;
        for (int i = 0; i < 4; ++i) { const int u = vcu * 4 + i; if (u < BATCH * 128) att::sb_unit(u >> 7, u & 127, i & 1, QKV, OB, shm); }
        __syncthreads();
    }
    if (IN(PH_ATT_DF)) {
        char* shm = (char*)lds_raw;
        const int lane = fresh_lane();
        float d1 = P.lq1()[lane] * P.lk1()[lane], d2 = P.lq2()[lane] * P.lk2()[lane];
        const float lam = __expf(wave_sum(d1)) - __expf(wave_sum(d2)) + LAMBDA_INIT;
        if (vcu < 256) {
            const int bh = vcu >> 3, s = vcu & 7, b = bh >> 2, h = bh & 3;
            const float slope2 = exp2f(-2.0f * (float)(h + 1)) * LOG2E;
            for (int i = 0; i < 4; ++i) { const int qb = (i == 0) ? s : (i == 1) ? 31 - s : (i == 2) ? 15 - s : 16 + s; att::df_unit(b, h, qb, QKV, OB, shm, lam, slope2); }
        }
    }
    SEAM(PH_ATT_DF);
    if (IN(PH_OUTPROJ)) {
        pg8::Gemm g{OB, (const bf16_t*)(args.ws + WS_WOUT), 1024, nullptr, 0}; pg8::StaticOrder S; S.init(NTOK, DM, G, bx);
        pg8::EpiResBf16 E{P.x(), XN};
        pg8::gemm_phase<pg8::EpiResBf16, pg8::StaticOrder, false>(lds, g, S, E);
    }
    SEAM(PH_OUTPROJ);
    if (IN(PH_ROUTER)) { const int lane = fresh_lane(); p4_router(P, lds, ctl, vcu, G, wave * 64 + lane, lane, wave); }
    SEAM(PH_ROUTER);
    if (IN(PH_GATEUP)) {
        pg8::Gemm g{XN, (const bf16_t*)(args.ws + WS_WGU), 1024, (const int*)(args.ws + WS_LIST), 0}; pg8::GroupedOrder S; S.init(ctl + CW_CNT, (LAS int*)(lds + LDSCTL_OFF), G, bx, 1, 1024);
        pg8::EpiSwiGLU E{(bf16_t*)(args.ws + WS_HID), (const int*)(args.ws + WS_LIST), (const float*)(args.ws + WS_RSTD2)};
        pg8::gemm_phase<pg8::EpiSwiGLU, pg8::GroupedOrder, true>(lds, g, S, E);
    }
    SEAM(PH_GATEUP);
    if (IN(PH_DOWN)) {
        pg8::Gemm g{(const bf16_t*)(args.ws + WS_HID), (const bf16_t*)(args.ws + WS_WD), 512, nullptr, 0}; pg8::GroupedOrder S; S.init(ctl + CW_CNT, (LAS int*)(lds + LDSCTL_OFF + 64), G, bx, 0, 1024);
        pg8::EpiDown E{(bf16_t*)(args.ws + WS_YB), (const int*)(args.ws + WS_LIST)};
        pg8::gemm_phase<pg8::EpiDown, pg8::GroupedOrder, false>(lds, g, S, E);
    }
    SEAM(PH_DOWN);
    if (IN(PH_ROWS_X2)) { p7_rows(P, gw, NGW, fresh_lane()); }
    SEAM(PH_ROWS_X2);
    if (IN(PH_PLE_PROJ)) {
        pg8::Gemm g{(const bf16_t*)(args.ws + WS_PB), (const bf16_t*)(args.ws + WS_WPP), 256, nullptr, 0}; pg8::StaticOrder S; S.init(NTOK, DM, G, bx);
        pg8::EpiBf16 E{(bf16_t*)(args.ws + WS_PP), DM};
        pg8::gemm_phase<pg8::EpiBf16, pg8::StaticOrder, false>(lds, g, S, E);
    }
    SEAM(PH_PLE_PROJ);
    if (IN(PH_PLE_GATE)) {
        pg8::Gemm g{(const bf16_t*)(args.ws + WS_X2B), (const bf16_t*)(args.ws + WS_WPG), 1024, nullptr, 0}; pg8::StaticOrder S; S.init(NTOK, DM, G, bx);
        pg8::EpiPle E{P.out, (const bf16_t*)(args.ws + WS_X2B), (const bf16_t*)(args.ws + WS_PP), (const float*)(args.ws + WS_RSTD3)};
        pg8::gemm_phase<pg8::EpiPle, pg8::StaticOrder, false>(lds, g, S, E);
    }
    SEAM(PH_PLE_GATE);
    if (IN(PH_FINAL)) { p10_rows(P, gw, NGW, fresh_lane()); }
#undef IN
#undef SEAM
}

#ifndef PROBE_REPEAT
#define PROBE_REPEAT -1
#endif
extern "C" void kernel_launch(void* const* d_in, const int* in_sizes, int n_in, void* d_out, int out_size, void* d_ws, size_t ws_size, hipStream_t stream) {
    static int grid = 0;
    if (grid == 0) {
        if (n_in != 23 || in_sizes[0] != NTOK * DM || out_size != NTOK * DM || ws_size < WS_END) { fprintf(stderr, "kernel_launch: unexpected shapes (n_in %d, in0 %d, out %d, ws %zu; need ws >= %zu); nothing launched\n", n_in, n_in > 0 ? in_sizes[0] : -1, out_size, ws_size, (size_t)WS_END); grid = -1; return; }
        int dev = 0, cus = 0, per_cu = 0;
        if (hipGetDevice(&dev) != hipSuccess || hipDeviceGetAttribute(&cus, hipDeviceAttributeMultiprocessorCount, dev) != hipSuccess) { fprintf(stderr, "kernel_launch: device query failed\n"); grid = -1; return; }
        if (hipFuncSetAttribute((const void*)hymba_fwd, hipFuncAttributeMaxDynamicSharedMemorySize, LDS_BYTES) != hipSuccess) { fprintf(stderr, "kernel_launch: hipFuncSetAttribute failed\n"); grid = -1; return; }
        if (hipOccupancyMaxActiveBlocksPerMultiprocessor(&per_cu, (const void*)hymba_fwd, NWAVES * 64, LDS_BYTES) != hipSuccess || per_cu < 1) { fprintf(stderr, "kernel_launch: occupancy query says %d blocks per CU; nothing launched\n", per_cu); (void)hipGetLastError(); grid = -1; return; }
        grid = cus;
        fprintf(stderr, "kernel_launch: %d CUs, occupancy %d/CU, grid %d\n", cus, per_cu, grid);
    }
    if (grid < 0) return;
    if (hipMemsetAsync((char*)d_ws + WS_CTL, 0, CTL_ZERO_BYTES, stream) != hipSuccess) { fprintf(stderr, "kernel_launch: memset failed\n"); return; }
    Args a{};
    for (int i = 0; i < 23; ++i) a.in[i] = (const float*)d_in[i];
    a.out = (float*)d_out; a.ws = (unsigned char*)d_ws;
#if MK_N_LAUNCHES == 1
    a.ph_lo = 0; a.ph_hi = PH_COUNT;
    void* kargs[] = {&a};
    hipError_t e = hipLaunchCooperativeKernel((const void*)hymba_fwd, dim3(grid), dim3(NWAVES * 64), kargs, LDS_BYTES, stream);
    if (e != hipSuccess) fprintf(stderr, "kernel_launch: cooperative launch failed: %s (grid %d)\n", hipGetErrorString(e), grid);
#else
    for (int li = 0; li < PH_COUNT; ++li) {
        a.ph_lo = li; a.ph_hi = li + 1;
        for (int r = 0; r < (li == PROBE_REPEAT ? 2 : 1); ++r) { if (r == 1 && li == PH_ROUTER) (void)hipMemsetAsync((char*)d_ws + WS_CTL, 0, CTL_ZERO_BYTES, stream); hipLaunchKernelGGL(hymba_fwd, dim3(grid), dim3(NWAVES * 64), LDS_BYTES, stream, a); }
    }
#endif
}
```
